# Optimizing an MI355X kernel written in HIP

```python
import jax, jax.numpy as jnp
from jax import lax
import numpy as np

D_MODEL = 1024
BATCH = 4
SEQ = 8192
DEPTH = 1

CHUNK = 64
Q_BLOCK = 128
A_HEADS = 8
A_HEAD_DIM = 64
A_WIDTH = A_HEADS * A_HEAD_DIM
B_HEADS = 8
B_Q_RANK = 256
B_KV_RANK = 128
B_NOPE = 64
B_ROPE = 32
B_V_DIM = 64
B_WIDTH = B_HEADS * B_V_DIM
ROPE_BASE = 10000.0
FFN_HIDDEN = 2816
NORM_EPS = 1e-6
NEG_INF = -1e30
IN_SIZES = (A_WIDTH, A_WIDTH, A_WIDTH, A_HEADS, B_Q_RANK, B_KV_RANK, B_ROPE, D_MODEL, D_MODEL)
IN_WIDTH = 3 * A_WIDTH + A_HEADS + B_Q_RANK + B_KV_RANK + B_ROPE + 2 * D_MODEL

kernel_name = "hybrid_fox_mla_gated_block"


def rms_norm(x, g):
    xf = x.astype(jnp.float32)
    y = xf * lax.rsqrt(jnp.mean(xf * xf, axis=-1, keepdims=True) + NORM_EPS)
    return (y * g.astype(jnp.float32)).astype(x.dtype)


def rope_cos_sin(positions):
    half = B_ROPE // 2
    inv_freq = ROPE_BASE ** (-jnp.arange(half, dtype=jnp.float32) / half)
    ang = positions.astype(jnp.float32)[..., None] * inv_freq
    return jnp.cos(ang), jnp.sin(ang)


def apply_rope(x, cos, sin):
    xf = x.astype(jnp.float32)
    x1, x2 = jnp.split(xf, 2, axis=-1)
    out = jnp.concatenate([x1 * cos - x2 * sin, x2 * cos + x1 * sin], axis=-1)
    return out.astype(x.dtype)


def to_blocks(t):
    b, s = t.shape[0], t.shape[1]
    return t.reshape((b, s // Q_BLOCK, Q_BLOCK) + t.shape[2:]).swapaxes(0, 1)


def from_blocks(t):
    t = t.swapaxes(0, 1)
    return t.reshape((t.shape[0], t.shape[1] * t.shape[2]) + t.shape[3:])


def forgetting_attention(q, k, v, log_f):
    s_len = q.shape[1]
    nb = s_len // Q_BLOCK
    scale = A_HEAD_DIM ** -0.5
    c = jnp.cumsum(log_f, axis=1)
    c_keys = c.transpose(0, 2, 1)
    k_pos = jnp.arange(s_len)

    def one_block(args):
        i, q_i, c_i = args
        q_pos = i * Q_BLOCK + jnp.arange(Q_BLOCK)
        s = jnp.einsum('bqhd,bkhd->bhqk', q_i, k, preferred_element_type=jnp.float32) * scale
        bias = c_i.transpose(0, 2, 1)[..., :, None] - c_keys[..., None, :]
        mask = k_pos[None, :] <= q_pos[:, None]
        s = jnp.where(mask, s + bias, NEG_INF)
        p = jax.nn.softmax(s, axis=-1).astype(v.dtype)
        return jnp.einsum('bhqk,bkhd->bqhd', p, v)

    out = lax.map(one_block, (jnp.arange(nb), to_blocks(q), to_blocks(c)))
    return from_blocks(out)


def latent_attention(q_nope, q_rope, k_nope, k_rope, v):
    s_len = q_nope.shape[1]
    nb = s_len // Q_BLOCK
    scale = (B_NOPE + B_ROPE) ** -0.5
    k_chunk = jnp.arange(s_len) // CHUNK

    def one_block(args):
        i, qn, qr = args
        q_chunk = (i * Q_BLOCK + jnp.arange(Q_BLOCK)) // CHUNK
        s = (jnp.einsum('bqhd,bkhd->bhqk', qn, k_nope, preferred_element_type=jnp.float32)
             + jnp.einsum('bqhr,bkr->bhqk', qr, k_rope, preferred_element_type=jnp.float32))
        s = jnp.where(k_chunk[None, :] <= q_chunk[:, None], s * scale, NEG_INF)
        p = jax.nn.softmax(s, axis=-1).astype(v.dtype)
        return jnp.einsum('bhqk,bkhd->bqhd', p, v)

    out = lax.map(one_block, (jnp.arange(nb), to_blocks(q_nope), to_blocks(q_rope)))
    return from_blocks(out)


def hybrid_mixer(xn, cos, sin, w_in, b_forget, q_a_norm_g, w_q_up, kv_a_norm_g, w_kv_up,
                 w_branch_a, w_branch_b, b_gate, w_out):
    bsz, s_len, _ = xn.shape
    splits = [int(v) for v in np.cumsum(IN_SIZES)[:-1]]
    proj = xn @ w_in
    qa, ka, va, fa, cq, ckv, kr, ga, gb = jnp.split(proj, splits, axis=-1)

    qa = qa.reshape(bsz, s_len, A_HEADS, A_HEAD_DIM)
    ka = ka.reshape(bsz, s_len, A_HEADS, A_HEAD_DIM)
    va = va.reshape(bsz, s_len, A_HEADS, A_HEAD_DIM)
    log_f = jax.nn.log_sigmoid((fa + b_forget).astype(jnp.float32))
    ya = forgetting_attention(qa, ka, va, log_f).reshape(bsz, s_len, A_WIDTH)

    qb = (rms_norm(cq, q_a_norm_g) @ w_q_up).reshape(bsz, s_len, B_HEADS, B_NOPE + B_ROPE)
    q_nope, q_rope = qb[..., :B_NOPE], qb[..., B_NOPE:]
    q_rope = apply_rope(q_rope, cos[:, :, None, :], sin[:, :, None, :])
    kv = (rms_norm(ckv, kv_a_norm_g) @ w_kv_up).reshape(bsz, s_len, B_HEADS, B_NOPE + B_V_DIM)
    k_nope, vb = kv[..., :B_NOPE], kv[..., B_NOPE:]
    k_rope = apply_rope(kr, cos, sin)
    yb = latent_attention(q_nope, q_rope, k_nope, k_rope, vb).reshape(bsz, s_len, B_WIDTH)

    gate_a = jax.nn.sigmoid(ga + b_gate[:D_MODEL])
    gate_b = jax.nn.sigmoid(gb + b_gate[D_MODEL:])
    merged = gate_a * (ya @ w_branch_a) + gate_b * (yb @ w_branch_b)
    return merged @ w_out


def swiglu(xn, w_gate, w_up, w_down):
    return (jax.nn.silu(xn @ w_gate) * (xn @ w_up)) @ w_down


def setup_inputs(seed: int = 0) -> dict:
    key = jax.random.key(seed)
    ks = jax.random.split(key, 20)
    f32 = jnp.float32

    def w(k, shape, fan_in):
        return jax.random.normal(k, shape, f32) * (fan_in ** -0.5)

    def gain(k, shape):
        return 1.0 + 0.05 * jax.random.normal(k, shape, f32)

    x = jax.random.normal(ks[0], (BATCH, SEQ, D_MODEL), f32)
    offsets = jax.random.randint(ks[1], (BATCH, 1), 0, 100000, dtype=jnp.int32)
    positions = offsets + jnp.arange(SEQ, dtype=jnp.int32)[None, :]
    return {
        "x": x,
        "positions": positions,
        "norm_mix_g": gain(ks[2], (DEPTH, D_MODEL)),
        "w_in": w(ks[3], (DEPTH, D_MODEL, IN_WIDTH), D_MODEL),
        "b_forget": jax.random.uniform(ks[4], (DEPTH, A_HEADS), f32, 1.0, 5.0),
        "q_a_norm_g": gain(ks[5], (DEPTH, B_Q_RANK)),
        "w_q_up": w(ks[6], (DEPTH, B_Q_RANK, B_HEADS * (B_NOPE + B_ROPE)), B_Q_RANK),
        "kv_a_norm_g": gain(ks[7], (DEPTH, B_KV_RANK)),
        "w_kv_up": w(ks[8], (DEPTH, B_KV_RANK, B_HEADS * (B_NOPE + B_V_DIM)), B_KV_RANK),
        "w_branch_a": w(ks[9], (DEPTH, A_WIDTH, D_MODEL), A_WIDTH),
        "w_branch_b": w(ks[10], (DEPTH, B_WIDTH, D_MODEL), B_WIDTH),
        "b_gate": 0.02 * jax.random.normal(ks[11], (DEPTH, 2 * D_MODEL), f32),
        "w_out": w(ks[12], (DEPTH, D_MODEL, D_MODEL), D_MODEL),
        "norm_ffn_g": gain(ks[13], (DEPTH, D_MODEL)),
        "w_ffn_gate": w(ks[14], (DEPTH, D_MODEL, FFN_HIDDEN), D_MODEL),
        "w_ffn_up": w(ks[15], (DEPTH, D_MODEL, FFN_HIDDEN), D_MODEL),
        "w_ffn_down": w(ks[16], (DEPTH, FFN_HIDDEN, D_MODEL), FFN_HIDDEN),
        "norm_final_g": gain(ks[17], (D_MODEL,)),
    }


def reference(x, positions, norm_mix_g, w_in, b_forget, q_a_norm_g, w_q_up, kv_a_norm_g,
              w_kv_up, w_branch_a, w_branch_b, b_gate, w_out, norm_ffn_g, w_ffn_gate,
              w_ffn_up, w_ffn_down, norm_final_g):
    cos, sin = rope_cos_sin(positions)
    h = x
    for l in range(DEPTH):
        xn = rms_norm(h, norm_mix_g[l])
        h = h + hybrid_mixer(xn, cos, sin, w_in[l], b_forget[l], q_a_norm_g[l], w_q_up[l],
                             kv_a_norm_g[l], w_kv_up[l], w_branch_a[l], w_branch_b[l],
                             b_gate[l], w_out[l])
        hn = rms_norm(h, norm_ffn_g[l])
        h = h + swiglu(hn, w_ffn_gate[l], w_ffn_up[l], w_ffn_down[l])
    return rms_norm(h, norm_final_g)
```

```cpp
#include <hip/hip_runtime.h>
#include <hip/hip_cooperative_groups.h>
#include <cstdio>
#include <cstdint>
namespace cg = cooperative_groups;
namespace pg8 {
#define PG8_LAS __attribute__((address_space(3)))
typedef unsigned short bf16_t;
typedef short bf16x8 __attribute__((ext_vector_type(8)));
typedef float f32x4 __attribute__((ext_vector_type(4)));
typedef unsigned u32x4 __attribute__((ext_vector_type(4)));
constexpr int BM = 256, BK = 64, HALF = 128, HTB = HALF * BK * 2  , STAGE_BYTES = 8 * HTB, NXCD = 8, WGM = 4;

__host__ __device__ __forceinline__ int lds_byte(int r, int c) { const int st = (r >> 4) * 2 + (c >> 5), rr = r & 15, cc = c & 31, ob = rr * 64 + cc * 2; return st * 1024 + (ob ^ (((ob >> 9) & 1) << 5)); }
__host__ __device__ __forceinline__ void stage_rc(int b, int& R, int& C) { const int st = b / 1024, sb = b % 1024, swz = sb ^ (((sb >> 9) & 1) << 5); R = (st >> 1) * 16 + swz / 64; C = (st & 1) * 32 + (swz % 64) / 2; }
__host__ __device__ __forceinline__ int perm32(int rho) { const int n = rho >> 4, i = rho & 15; return 8 * (i >> 2) + 4 * n + (i & 3); }

struct Unit { int pm, pn; };
struct Gemm { const bf16_t* A; const bf16_t* Bt; int M, N, K; };

struct StaticOrder {
    int nM, nN, nwg, G, c;
    __host__ __device__ void init(int M, int N, int G_, int c_) { nM = M / BM; nN = N / BM; nwg = nM * nN; G = G_; c = c_; }
    __host__ __device__ bool next(int i, Unit& u) const {
        const long L = (long)i * G + c; if (L >= nwg) return false;
        int wgid = (int)L; { const int q = nwg / NXCD, r = nwg % NXCD, xcd = wgid % NXCD, off = wgid / NXCD; wgid = (xcd < r ? xcd * (q + 1) : r * (q + 1) + (xcd - r) * q) + off; }
        const int nig = WGM * nN, gid = wgid / nig, fm = gid * WGM, gsz = (nM - fm) < WGM ? (nM - fm) : WGM;
        u.pm = fm + ((wgid % nig) % gsz); u.pn = (wgid % nig) / gsz; return true;
    }
    __device__ __forceinline__ void a_ready(const Unit&) const {}
    __device__ __forceinline__ void done(const Unit&) const {}
};

typedef float f32x2c __attribute__((ext_vector_type(2))); typedef __bf16 bf16x2c __attribute__((ext_vector_type(2)));
__device__ __forceinline__ unsigned cvt_pk_bf16(float lo, float hi) { const f32x2c v = {lo, hi}; const bf16x2c b = __builtin_convertvector(v, bf16x2c); return __builtin_bit_cast(unsigned, b); }
template <class Epi, class Sched, bool ALIGN_EPI = false, bool SP2 = false>
__device__ __forceinline__ void gemm_phase(PG8_LAS unsigned char* lds, const Gemm g, const Sched& S, const Epi& E) {
    int tid_ = threadIdx.x; asm volatile("" : "+v"(tid_));
    const int tid = tid_, wid = __builtin_amdgcn_readfirstlane(tid >> 6), lane = tid & 63, wr = wid >> 2, wc = wid & 3, fr = lane & 15, fq = lane >> 4;
    const int K = g.K, nt = K / BK;
    unsigned voffA[2], voffB[2];
#pragma unroll
    for (int i = 0; i < 2; ++i) { int R, C; stage_rc(tid * 16 + i * 8192, R, C); const int Rb = Epi::PERM ? ((R & ~31) + perm32(R & 31)) : R;
        voffA[i] = (unsigned)(R * K + C) * 2u; voffB[i] = (unsigned)(Rb * K + C) * 2u; }
    const size_t kstep = (size_t)(BK * 2);
    const size_t hstep = (size_t)HALF * K * 2;
    const size_t tstep = 2 * hstep;
    const unsigned ldsw = (unsigned)wid * 1024u;
    const int aoff = lds_byte(wr * 64 + fr, fq * 8), boff = lds_byte(wc * 32 + fr, fq * 8);
#define PG8_SA(b, h) (((b) * 2 + (h)) * HTB)
#define PG8_SB(b, h) ((4 + (b) * 2 + (h)) * HTB)
#define PG8_STAGE(bufoff, gbase, voff) do { _Pragma("unroll") for (int _i = 0; _i < 2; ++_i) \
        __builtin_amdgcn_global_load_lds((const unsigned*)((const char*)(gbase) + (voff)[_i]), (PG8_LAS unsigned*)(lds + (bufoff) + ldsw + _i * 8192), 16, 0, 0); } while (0)
#define PG8_LDA(dst, b, h) do { _Pragma("unroll") for (int m = 0; m < 4; ++m) _Pragma("unroll") for (int k = 0; k < 2; ++k) dst[m][k] = *(const PG8_LAS bf16x8*)(lds + PG8_SA(b, h) + aoff + m * 2048 + k * 1024); } while (0)
#define PG8_LDB(dst, b, h) do { _Pragma("unroll") for (int n = 0; n < 2; ++n) _Pragma("unroll") for (int k = 0; k < 2; ++k) dst[n][k] = *(const PG8_LAS bf16x8*)(lds + PG8_SB(b, h) + boff + n * 2048 + k * 1024); } while (0)
#define PG8_MMA(ai, bj, At, Bt) do { __builtin_amdgcn_s_setprio(1); _Pragma("unroll") for (int m = 0; m < 4; ++m) _Pragma("unroll") for (int n = 0; n < 2; ++n) _Pragma("unroll") for (int k = 0; k < 2; ++k) \
        acc[ai][bj][m][n] = __builtin_amdgcn_mfma_f32_16x16x32_bf16(Bt[n][k], At[m][k], acc[ai][bj][m][n], 0, 0, 0); __builtin_amdgcn_s_setprio(0); } while (0)
#define PG8_WAIT_V(n) asm volatile("s_waitcnt vmcnt(" #n ")" ::: "memory")
#define PG8_WAIT_L(n) asm volatile("s_waitcnt lgkmcnt(" #n ")" ::: "memory")
#define PG8_BAR __builtin_amdgcn_s_barrier()
#define PG8_SCHED __builtin_amdgcn_sched_barrier(0)
    Unit cur, nxt; int ui = 0;
    if (!S.next(0, cur)) return;
    f32x4 acc[2][2][4][2];
#pragma unroll
    for (int a = 0; a < 2; ++a)
#pragma unroll
        for (int b = 0; b < 2; ++b)
#pragma unroll
            for (int m = 0; m < 4; ++m)
#pragma unroll
                for (int n = 0; n < 2; ++n) acc[a][b][m][n] = (f32x4){0.f, 0.f, 0.f, 0.f};
    bf16x8 At[4][2], B0[2][2], B1[2][2];
    const char* cA = (const char*)g.A + (size_t)cur.pm * tstep; const char* cB = (const char*)g.Bt + (size_t)cur.pn * tstep;
    S.a_ready(cur);
    if constexpr (SP2) {
        PG8_STAGE(PG8_SB(0, 0), cB, voffB); PG8_STAGE(PG8_SB(0, 1), cB + hstep, voffB); PG8_STAGE(PG8_SA(0, 0), cA, voffA); PG8_STAGE(PG8_SA(0, 1), cA + hstep, voffA);
        if (wr == 1) PG8_BAR;
        PG8_WAIT_V(2); PG8_BAR;
        PG8_STAGE(PG8_SB(1, 0), cB + kstep, voffB); PG8_STAGE(PG8_SA(1, 0), cA + kstep, voffA); PG8_STAGE(PG8_SB(1, 1), cB + hstep + kstep, voffB);
        PG8_WAIT_V(6); PG8_BAR;
    } else {
        PG8_STAGE(PG8_SB(0, 0), cB, voffB); PG8_STAGE(PG8_SA(0, 0), cA, voffA); PG8_STAGE(PG8_SB(0, 1), cB + hstep, voffB); PG8_STAGE(PG8_SA(0, 1), cA + hstep, voffA);
        if (wr == 1) PG8_BAR;
        PG8_WAIT_V(4); PG8_BAR;
        PG8_STAGE(PG8_SB(1, 0), cB + kstep, voffB); PG8_STAGE(PG8_SA(1, 0), cA + kstep, voffA); PG8_STAGE(PG8_SB(1, 1), cB + hstep + kstep, voffB);
        PG8_WAIT_V(6); PG8_BAR;
    }
    for (;;) {
        const bool has_next = S.next(ui + 1, nxt);
        const char* nA = has_next ? (const char*)g.A + (size_t)nxt.pm * tstep : cA; const char* nB = has_next ? (const char*)g.Bt + (size_t)nxt.pn * tstep : cB;
        for (int t = 0; t < nt; t += 2) {
            if constexpr (Epi::HAS_MID) { if (t == (nt >> 1)) E.mid(acc, cur, wr, wc, fr, fq); }
            const bool last = (t == nt - 2);
            const char* a1 = cA + (size_t)(t + 1) * kstep;
            const char* a2 = last ? nA : cA + (size_t)(t + 2) * kstep; const char* b2 = last ? nB : cB + (size_t)(t + 2) * kstep;
            const char* a3 = a2 + kstep; const char* b3 = b2 + kstep;
            if (last && has_next) S.a_ready(nxt);
            if constexpr (SP2) {
            PG8_LDB(B0, 0, 0); PG8_LDB(B1, 0, 1); PG8_SCHED; PG8_LDA(At, 0, 0); PG8_STAGE(PG8_SA(1, 1), a1 + hstep, voffA);
            PG8_WAIT_V(8); PG8_WAIT_L(0); PG8_BAR; PG8_MMA(0, 0, At, B0); PG8_MMA(0, 1, At, B1); PG8_BAR; PG8_SCHED;
            PG8_LDA(At, 0, 1); PG8_STAGE(PG8_SB(0, 0), b2, voffB); PG8_STAGE(PG8_SB(0, 1), b2 + hstep, voffB); PG8_STAGE(PG8_SA(0, 0), a2, voffA);
            PG8_WAIT_V(8); PG8_WAIT_L(0); PG8_BAR; PG8_MMA(1, 0, At, B0); PG8_MMA(1, 1, At, B1); PG8_BAR; PG8_SCHED;
            PG8_LDB(B0, 1, 0); PG8_LDB(B1, 1, 1); PG8_SCHED; PG8_LDA(At, 1, 0); PG8_STAGE(PG8_SA(0, 1), a2 + hstep, voffA);
            PG8_WAIT_V(8); PG8_WAIT_L(0); PG8_BAR; PG8_MMA(0, 0, At, B0); PG8_MMA(0, 1, At, B1); PG8_BAR; PG8_SCHED;
            PG8_LDA(At, 1, 1); PG8_STAGE(PG8_SB(1, 0), b3, voffB); PG8_STAGE(PG8_SB(1, 1), b3 + hstep, voffB); PG8_STAGE(PG8_SA(1, 0), a3, voffA);
            PG8_WAIT_V(8); PG8_WAIT_L(0); PG8_BAR; PG8_MMA(1, 0, At, B0); PG8_MMA(1, 1, At, B1); PG8_BAR; PG8_SCHED;
            } else {
            PG8_LDB(B0, 0, 0); PG8_SCHED; PG8_LDA(At, 0, 0); PG8_STAGE(PG8_SA(1, 1), a1 + hstep, voffA);
            PG8_WAIT_L(8); PG8_BAR; PG8_WAIT_L(0); PG8_MMA(0, 0, At, B0); PG8_BAR; PG8_SCHED;
            PG8_LDB(B1, 0, 1); PG8_STAGE(PG8_SB(0, 0), b2, voffB);
            PG8_BAR; PG8_WAIT_L(0); PG8_MMA(0, 1, At, B1); PG8_BAR;
            PG8_LDA(At, 0, 1); PG8_STAGE(PG8_SA(0, 0), a2, voffA);
            PG8_BAR; PG8_WAIT_L(0); PG8_MMA(1, 0, At, B0); PG8_BAR; PG8_SCHED;
            PG8_STAGE(PG8_SB(0, 1), b2 + hstep, voffB);
            PG8_WAIT_V(6); PG8_BAR; PG8_MMA(1, 1, At, B1); PG8_BAR;
            PG8_LDB(B0, 1, 0); PG8_SCHED; PG8_LDA(At, 1, 0); PG8_STAGE(PG8_SA(0, 1), a2 + hstep, voffA);
            PG8_WAIT_L(8); PG8_BAR; PG8_WAIT_L(0); PG8_MMA(0, 0, At, B0); PG8_BAR; PG8_SCHED;
            PG8_LDB(B1, 1, 1); PG8_STAGE(PG8_SB(1, 0), b3, voffB);
            PG8_BAR; PG8_WAIT_L(0); PG8_MMA(0, 1, At, B1); PG8_BAR;
            PG8_LDA(At, 1, 1); PG8_STAGE(PG8_SA(1, 0), a3, voffA);
            PG8_BAR; PG8_WAIT_L(0); PG8_MMA(1, 0, At, B0); PG8_BAR; PG8_SCHED;
            PG8_STAGE(PG8_SB(1, 1), b3 + hstep, voffB);
            PG8_WAIT_V(6); PG8_BAR; PG8_MMA(1, 1, At, B1); PG8_BAR;
            }
        }
        if constexpr (ALIGN_EPI) { if (wr == 0) PG8_BAR; }
        if constexpr (!Epi::AFTER_DRAIN) { E(acc, cur, wr, wc, fr, fq); S.done(cur); }
        if (!has_next) break;
#pragma unroll
        for (int a = 0; a < 2; ++a)
#pragma unroll
            for (int b = 0; b < 2; ++b)
#pragma unroll
                for (int m = 0; m < 4; ++m)
#pragma unroll
                    for (int n = 0; n < 2; ++n) acc[a][b][m][n] = (f32x4){0.f, 0.f, 0.f, 0.f};
        cur = nxt; cA = nA; cB = nB; ++ui;
        if constexpr (ALIGN_EPI) { if (wr == 1) PG8_BAR; }
    }
    PG8_WAIT_V(0);
    if constexpr (!ALIGN_EPI) { if (wr == 0) PG8_BAR; }
    PG8_BAR;
    if constexpr (Epi::AFTER_DRAIN) { E.fused(acc, cur, wr, wc, fr, fq, lds, wid, lane); S.done(cur); }
#undef PG8_SA
#undef PG8_SB
#undef PG8_STAGE
#undef PG8_LDA
#undef PG8_LDB
#undef PG8_MMA
#undef PG8_WAIT_V
#undef PG8_WAIT_L
#undef PG8_BAR
#undef PG8_SCHED
}
}

#define LAS __attribute__((address_space(3)))
typedef unsigned short bf16;
typedef pg8::f32x4 f32x4;
typedef pg8::u32x4 u32x4;
typedef unsigned u32x2 __attribute__((ext_vector_type(2)));
typedef float f32x2 __attribute__((ext_vector_type(2)));
typedef short s16x8 __attribute__((ext_vector_type(8)));
typedef float f32x16 __attribute__((ext_vector_type(16)));
typedef short s16x4 __attribute__((ext_vector_type(4)));
typedef short v4i16_t __attribute__((ext_vector_type(4)));
using pg8::Unit;
using pg8::cvt_pk_bf16;

constexpr int NB = 4, S = 8192, T = NB * S, DM = 1024, NH = 8, FFN = 2816;
constexpr int IN_W = 4008, IN_WP = 4096;
constexpr float EPS = 1e-6f;
constexpr float LOG2E = 1.4426950408889634f;
constexpr float QSC_A = 0.125f * LOG2E;
constexpr float QSC_B = 0.10206207261596577f * LOG2E;
constexpr int NWAVES = 8, NTHREADS = 512;
constexpr int LDS_BYTES = 147456;

constexpr size_t MiB = 1u << 20;
constexpr size_t WS_WIN = 1 * MiB, WS_WQ = 9 * MiB, WS_WKV = 9 * MiB + 512 * 1024, WS_WA = 10 * MiB, WS_WB = 11 * MiB, WS_WOUT = 12 * MiB,
                 WS_WGU = 14 * MiB, WS_WDN = 25 * MiB;
constexpr size_t WS_KR = 31 * MiB, WS_LOGF = 35 * MiB, WS_C = 36 * MiB, WS_PSQ = 37 * MiB, WS_PSKV = 37 * MiB + 512 * 1024, WS_CS = 38 * MiB,
                 WS_PSH = 42 * MiB, WS_KMAX = 44 * MiB;
constexpr size_t WS_XN = 48 * MiB;
constexpr size_t WS_YA = 48 * MiB, WS_YB = 80 * MiB;
constexpr size_t WS_QA = 112 * MiB, WS_KA = 144 * MiB, WS_VTA = 176 * MiB;
constexpr size_t WS_MERGED = 112 * MiB;
constexpr size_t WS_CQ = 208 * MiB, WS_CKV = 224 * MiB;
constexpr size_t WS_GA = 232 * MiB, WS_GB = 296 * MiB;
constexpr size_t WS_QB = 360 * MiB, WS_KB = 408 * MiB, WS_VTB = 456 * MiB;
constexpr size_t WS_HB = 360 * MiB, WS_H2B = 424 * MiB;
constexpr size_t WS_ACT = 48 * MiB;
constexpr size_t WS_END = 488 * MiB;

__device__ __forceinline__ int pos16(int k) { return (k & 3) | ((k & 4) << 1) | ((k & 8) >> 1); }
__device__ __forceinline__ unsigned bf1(float v) { return cvt_pk_bf16(v, 0.f) & 0xffffu; }
__device__ __forceinline__ u32x4 pack8(f32x4 a, f32x4 b) { u32x4 w; w.x = cvt_pk_bf16(a[0], a[1]); w.y = cvt_pk_bf16(a[2], a[3]); w.z = cvt_pk_bf16(b[0], b[1]); w.w = cvt_pk_bf16(b[2], b[3]); return w; }
__device__ __forceinline__ u32x2 pack4(f32x4 a) { u32x2 w; w.x = cvt_pk_bf16(a[0], a[1]); w.y = cvt_pk_bf16(a[2], a[3]); return w; }
__device__ __forceinline__ float bflo(unsigned w) { return __uint_as_float(w << 16); }
__device__ __forceinline__ float bfhi(unsigned w) { return __uint_as_float(w & 0xffff0000u); }
__device__ __forceinline__ float sigmoidf_(float z) { return __builtin_amdgcn_rcpf(1.f + __expf(-z)); }
__device__ __forceinline__ float sumsq4(f32x4 v) { return (v[0] * v[0] + v[1] * v[1]) + (v[2] * v[2] + v[3] * v[3]); }
__device__ __forceinline__ float red_fq(float s) { s += __shfl_xor(s, 16); s += __shfl_xor(s, 32); return s; }

#define ACC_T const f32x4 (&acc)[2][2][4][2]
#define FOR_AI_M _Pragma("unroll") for (int ai = 0; ai < 2; ++ai) _Pragma("unroll") for (int m = 0; m < 4; ++m)

__device__ __forceinline__ unsigned vt_lane_off(int fr, int fq) { return (unsigned)((8 * fq * S + pos16(fr & ~1)) * 2 + (fr & 1) * S * 2); }
__device__ __forceinline__ void store_vt(bf16* VT, int urow, int col, unsigned loff, f32x4 v, int fr) {
    const int b = urow >> 13, s = urow & (S - 1);
    unsigned char* ub = (unsigned char*)VT + ((size_t)(b * 512 + col) * S + s) * 2;
    const bool odd = (fr & 1) != 0;
    const float mine0 = odd ? v[1] : v[0], mine1 = odd ? v[3] : v[2];
    const float give0 = odd ? v[0] : v[1], give1 = odd ? v[2] : v[3];
    const float got0 = __shfl_xor(give0, 1), got1 = __shfl_xor(give1, 1);
    const unsigned w0 = odd ? cvt_pk_bf16(got0, mine0) : cvt_pk_bf16(mine0, got0);
    const unsigned w1 = odd ? cvt_pk_bf16(got1, mine1) : cvt_pk_bf16(mine1, got1);
    *(unsigned*)(ub + loff) = w0;
    *(unsigned*)(ub + (size_t)2 * S * 2 + loff) = w1;
}

struct EpiIn {
    static constexpr bool PERM = true, AFTER_DRAIN = false, HAS_MID = false;
    unsigned char* ws; const float *b_forget, *b_gate;
    __device__ __forceinline__ void operator()(ACC_T, const Unit& u, int wr, int wc, int fr, int fq) const {
        asm volatile("" : "+v"(fr), "+v"(fq));
        bf16 *QA = (bf16*)(ws + WS_QA), *KA = (bf16*)(ws + WS_KA), *VTA = (bf16*)(ws + WS_VTA), *CQ = (bf16*)(ws + WS_CQ), *CKV = (bf16*)(ws + WS_CKV), *GA = (bf16*)(ws + WS_GA), *GB = (bf16*)(ws + WS_GB);
        float *KR = (float*)(ws + WS_KR), *LOGF = (float*)(ws + WS_LOGF), *PSQ = (float*)(ws + WS_PSQ), *PSKV = (float*)(ws + WS_PSKV);
        const int pn = u.pn, rbase = u.pm * 256 + wr * 64 + fr, cl = wc * 32 + 8 * fq;
        if (pn < 4) {
            bf16* dst = pn < 2 ? QA : KA; const float sc = pn < 2 ? QSC_A : 1.f; const int c0 = (pn & 1) * 256 + cl;
            FOR_AI_M { int row = rbase + ai * 128 + m * 16; asm volatile("" : "+v"(row) :: "memory");
#pragma unroll
                for (int bj = 0; bj < 2; ++bj) *(u32x4*)(dst + (size_t)row * 512 + c0 + bj * 128) = pack8(acc[ai][bj][m][0] * sc, acc[ai][bj][m][1] * sc); }
        } else if (pn < 6) {
            const int c0 = (pn & 1) * 256 + cl;
            FOR_AI_M { int row = rbase + ai * 128 + m * 16; asm volatile("" : "+v"(row) :: "memory");
#pragma unroll
                for (int bj = 0; bj < 2; ++bj) *(u32x4*)(VTA + (size_t)row * 512 + c0 + bj * 128) = pack8(acc[ai][bj][m][0], acc[ai][bj][m][1]); }
        } else if (pn == 6) {
            FOR_AI_M { int row = rbase + ai * 128 + m * 16; asm volatile("" : "+v"(row) :: "memory"); float s = 0.f;
#pragma unroll
                for (int bj = 0; bj < 2; ++bj) { *(u32x4*)(CQ + (size_t)row * 256 + cl + bj * 128) = pack8(acc[ai][bj][m][0], acc[ai][bj][m][1]); s += sumsq4(acc[ai][bj][m][0]) + sumsq4(acc[ai][bj][m][1]); }
                s = red_fq(s); if (fq == 0) PSQ[(size_t)row * 4 + wc] = s; }
        } else if (pn == 7) {
            FOR_AI_M { int row = rbase + ai * 128 + m * 16; asm volatile("" : "+v"(row) :: "memory");
                *(u32x4*)(CKV + (size_t)row * 128 + cl) = pack8(acc[ai][0][m][0], acc[ai][0][m][1]);
                float s = sumsq4(acc[ai][0][m][0]) + sumsq4(acc[ai][0][m][1]); s = red_fq(s); if (fq == 0) PSKV[(size_t)row * 4 + wc] = s;
                if (wc == 0) { *(f32x4*)(KR + (size_t)row * 32 + 8 * fq) = acc[ai][1][m][0]; *(f32x4*)(KR + (size_t)row * 32 + 8 * fq + 4) = acc[ai][1][m][1]; }
                else if (wc == 1 && fq == 0) {
#pragma unroll
                    for (int n = 0; n < 2; ++n) { f32x4 o;
#pragma unroll
                        for (int e = 0; e < 4; ++e) { const float z = acc[ai][1][m][n][e] + b_forget[4 * n + e]; o[e] = fminf(z, 0.f) - __logf(1.f + __expf(-fabsf(z))); }
                        *(f32x4*)(LOGF + (size_t)row * 8 + 4 * n) = o; } } }
        } else {
            bf16* dst = pn < 12 ? GA : GB; const int c0 = ((pn - 8) & 3) * 256 + cl; const float* bg = b_gate + (pn < 12 ? 0 : DM) + c0;
            f32x4 bv[2][2];
#pragma unroll
            for (int bj = 0; bj < 2; ++bj)
#pragma unroll
                for (int n = 0; n < 2; ++n) bv[bj][n] = *(const f32x4*)(bg + bj * 128 + 4 * n);
            FOR_AI_M { int row = rbase + ai * 128 + m * 16; asm volatile("" : "+v"(row) :: "memory");
#pragma unroll
                for (int bj = 0; bj < 2; ++bj) { f32x4 a = acc[ai][bj][m][0] + bv[bj][0], b = acc[ai][bj][m][1] + bv[bj][1];
#pragma unroll
                    for (int e = 0; e < 4; ++e) { a[e] = fmaxf(sigmoidf_(a[e]), 1e-30f); b[e] = fmaxf(sigmoidf_(b[e]), 1e-30f); }
                    *(u32x4*)(dst + (size_t)row * DM + c0 + bj * 128) = pack8(a, b); } }
        }
    }
};

struct EpiQup {
    static constexpr bool PERM = false, AFTER_DRAIN = false, HAS_MID = false;
    bf16 *QN, *QR; const float* PSQ; const float* CS;
    __device__ __forceinline__ void operator()(ACC_T, const Unit& u, int wr, int wc, int fr, int fq) const {
        asm volatile("" : "+v"(fr), "+v"(fq));
        const int pn = u.pn, rbase = u.pm * 256 + wr * 64 + fr;
        FOR_AI_M { int row = rbase + ai * 128 + m * 16; asm volatile("" : "+v"(row) :: "memory");
            const f32x4 ps = *(const f32x4*)(PSQ + (size_t)row * 4);
            const float r = rsqrtf(((ps[0] + ps[1]) + (ps[2] + ps[3])) * (1.f / 256.f) + EPS) * QSC_B;
            if (pn < 2) {
#pragma unroll
                for (int bj = 0; bj < 2; ++bj)
#pragma unroll
                    for (int n = 0; n < 2; ++n) { const int c = pn * 256 + bj * 128 + wc * 32 + 16 * n + 4 * fq; *(u32x2*)(QN + (size_t)row * 512 + c) = pack4(acc[ai][bj][m][n] * r); }
            } else {
                const f32x4 cs0 = *(const f32x4*)(CS + (size_t)row * 32 + 8 * fq), cs1 = *(const f32x4*)(CS + (size_t)row * 32 + 8 * fq + 4);
                const f32x4 c = {cs0[0], cs0[2], cs1[0], cs1[2]}, sn = {cs0[1], cs0[3], cs1[1], cs1[3]};
#pragma unroll
                for (int bj = 0; bj < 2; ++bj) { const int hh = 4 * bj + wc; const f32x4 x1 = acc[ai][bj][m][0], x2 = acc[ai][bj][m][1];
                    *(u32x2*)(QR + (size_t)row * 256 + hh * 32 + 4 * fq) = pack4((x1 * c - x2 * sn) * r);
                    *(u32x2*)(QR + (size_t)row * 256 + hh * 32 + 16 + 4 * fq) = pack4((x2 * c + x1 * sn) * r); }
            } }
    }
};
struct EpiKVup {
    static constexpr bool PERM = true, AFTER_DRAIN = false, HAS_MID = false;
    bf16 *KN, *VTB; const float* PSKV;
    __device__ __forceinline__ void operator()(ACC_T, const Unit& u, int wr, int wc, int fr, int fq) const {
        asm volatile("" : "+v"(fr), "+v"(fq));
        const int pn = u.pn, rbase = u.pm * 256 + wr * 64 + fr, cl = wc * 32 + 8 * fq;
        FOR_AI_M { int row = rbase + ai * 128 + m * 16; asm volatile("" : "+v"(row) :: "memory");
            const f32x4 ps = *(const f32x4*)(PSKV + (size_t)row * 4);
            const float r = rsqrtf(((ps[0] + ps[1]) + (ps[2] + ps[3])) * (1.f / 128.f) + EPS);
            if (pn < 2) {
#pragma unroll
                for (int bj = 0; bj < 2; ++bj) *(u32x4*)(KN + (size_t)row * 512 + pn * 256 + bj * 128 + cl) = pack8(acc[ai][bj][m][0] * r, acc[ai][bj][m][1] * r);
            } else {
#pragma unroll
                for (int bj = 0; bj < 2; ++bj)
#pragma unroll
                    for (int n = 0; n < 2; ++n) store_vt(VTB, u.pm * 256 + wr * 64 + ai * 128 + m * 16, (pn - 2) * 256 + wc * 32 + bj * 128 + 4 * n, vt_lane_off(fr, fq), acc[ai][bj][m][n] * r, fr);
            } }
    }
};
struct EpiMerge {
    static constexpr bool PERM = true, AFTER_DRAIN = false, HAS_MID = true;
    const bf16 *GA_, *GB_; bf16* MG;
    __device__ __forceinline__ void mid(f32x4 (&acc)[2][2][4][2], const Unit& u, int wr, int wc, int fr, int fq) const {
        asm volatile("" : "+v"(fr), "+v"(fq));
        const int rbase = u.pm * 256 + wr * 64 + fr, c0 = u.pn * 256 + wc * 32 + 8 * fq;
        FOR_AI_M { int row = rbase + ai * 128 + m * 16; asm volatile("" : "+v"(row) :: "memory");
#pragma unroll
            for (int bj = 0; bj < 2; ++bj) { const size_t off = (size_t)row * DM + c0 + bj * 128; const u32x4 a = *(const u32x4*)(GA_ + off), b = *(const u32x4*)(GB_ + off);
                const f32x4 a0 = {bflo(a.x), bfhi(a.x), bflo(a.y), bfhi(a.y)}, a1 = {bflo(a.z), bfhi(a.z), bflo(a.w), bfhi(a.w)};
                const f32x4 b0 = {bflo(b.x), bfhi(b.x), bflo(b.y), bfhi(b.y)}, b1 = {bflo(b.z), bfhi(b.z), bflo(b.w), bfhi(b.w)};
                f32x4 r0, r1;
#pragma unroll
                for (int e = 0; e < 4; ++e) { r0[e] = a0[e] * __builtin_amdgcn_rcpf(b0[e]); r1[e] = a1[e] * __builtin_amdgcn_rcpf(b1[e]); }
                acc[ai][bj][m][0] *= r0; acc[ai][bj][m][1] *= r1; } }
    }
    __device__ __forceinline__ void operator()(ACC_T, const Unit& u, int wr, int wc, int fr, int fq) const {
        asm volatile("" : "+v"(fr), "+v"(fq));
        const int rbase = u.pm * 256 + wr * 64 + fr, c0 = u.pn * 256 + wc * 32 + 8 * fq;
        FOR_AI_M { int row = rbase + ai * 128 + m * 16; asm volatile("" : "+v"(row) :: "memory");
#pragma unroll
            for (int bj = 0; bj < 2; ++bj) { const size_t off = (size_t)row * DM + c0 + bj * 128; const u32x4 g = *(const u32x4*)(GB_ + off);
                const f32x4 g0 = {bflo(g.x), bfhi(g.x), bflo(g.y), bfhi(g.y)}, g1 = {bflo(g.z), bfhi(g.z), bflo(g.w), bfhi(g.w)};
                *(u32x4*)(MG + off) = pack8(acc[ai][bj][m][0] * g0, acc[ai][bj][m][1] * g1); } }
    }
};
struct EpiOut {
    static constexpr bool PERM = true, AFTER_DRAIN = false, HAS_MID = false;
    const float* X; bf16* HB; float* PS;
    __device__ __forceinline__ void operator()(ACC_T, const Unit& u, int wr, int wc, int fr, int fq) const {
        asm volatile("" : "+v"(fr), "+v"(fq));
        const int rbase = u.pm * 256 + wr * 64 + fr, c0 = u.pn * 256 + wc * 32 + 8 * fq;
        FOR_AI_M { int row = rbase + ai * 128 + m * 16; asm volatile("" : "+v"(row) :: "memory"); float s = 0.f;
#pragma unroll
            for (int bj = 0; bj < 2; ++bj) { const size_t off = (size_t)row * DM + c0 + bj * 128;
                const f32x4 h0 = *(const f32x4*)(X + off) + acc[ai][bj][m][0], h1 = *(const f32x4*)(X + off + 4) + acc[ai][bj][m][1];
                *(u32x4*)(HB + off) = pack8(h0, h1); s += sumsq4(h0) + sumsq4(h1); }
            s = red_fq(s); if (fq == 0) PS[((size_t)u.pn * T + row) * 4 + wc] = s; }
    }
};
struct EpiDown {
    static constexpr bool PERM = true, AFTER_DRAIN = false, HAS_MID = false;
    const bf16* HB; bf16* H2; float* PS;
    __device__ __forceinline__ void operator()(ACC_T, const Unit& u, int wr, int wc, int fr, int fq) const {
        asm volatile("" : "+v"(fr), "+v"(fq));
        const int rbase = u.pm * 256 + wr * 64 + fr, c0 = u.pn * 256 + wc * 32 + 8 * fq;
        FOR_AI_M { int row = rbase + ai * 128 + m * 16; asm volatile("" : "+v"(row) :: "memory"); float s = 0.f;
#pragma unroll
            for (int bj = 0; bj < 2; ++bj) { const size_t off = (size_t)row * DM + c0 + bj * 128; const u32x4 hq = *(const u32x4*)(HB + off);
                const f32x4 b0 = {bflo(hq.x), bfhi(hq.x), bflo(hq.y), bfhi(hq.y)}, b1 = {bflo(hq.z), bfhi(hq.z), bflo(hq.w), bfhi(hq.w)};
                const f32x4 h0 = b0 + acc[ai][bj][m][0], h1 = b1 + acc[ai][bj][m][1];
                *(u32x4*)(H2 + off) = pack8(h0, h1); s += sumsq4(h0) + sumsq4(h1); }
            s = red_fq(s); if (fq == 0) PS[((size_t)u.pn * T + row) * 4 + wc] = s; }
    }
};
struct EpiGU {
    static constexpr bool PERM = true, AFTER_DRAIN = false, HAS_MID = false;
    const float* PS; bf16* ACT;
    __device__ __forceinline__ void operator()(ACC_T, const Unit& u, int wr, int wc, int fr, int fq) const {
        asm volatile("" : "+v"(fr), "+v"(fq));
        const int rbase = u.pm * 256 + wr * 64 + fr, c0 = u.pn * 128 + wc * 32 + 8 * fq;
        FOR_AI_M { int row = rbase + ai * 128 + m * 16; asm volatile("" : "+v"(row) :: "memory");
            const f32x4* pp = (const f32x4*)(PS + (size_t)row * 4); const f32x4 p0 = pp[0], p1 = pp[T], p2 = pp[2 * T], p3 = pp[3 * T];
            const f32x4 pt = (p0 + p1) + (p2 + p3);
            const float r = rsqrtf(((pt[0] + pt[1]) + (pt[2] + pt[3])) * (1.f / 1024.f) + EPS);
            f32x4 o[2];
#pragma unroll
            for (int n = 0; n < 2; ++n)
#pragma unroll
                for (int e = 0; e < 4; ++e) { const float g = acc[ai][0][m][n][e] * r, up = acc[ai][1][m][n][e] * r; o[n][e] = g * sigmoidf_(g) * up; }
            *(u32x4*)(ACT + (size_t)row * FFN + c0) = pack8(o[0], o[1]); }
    }
};

namespace att {
__device__ __forceinline__ int crow(int r, int hi) { return (r & 3) + 8 * (r >> 2) + 4 * hi; }
__device__ __forceinline__ float max3f(float a, float b, float c) { return fmaxf(fmaxf(a, b), c); }

template <int NDC, bool FOX>
__device__ __forceinline__ void attn_unit(LAS unsigned char* lds, unsigned char* ws, int bh, int qb) {
    asm volatile("" : "+s"(ws));
    const bf16* Q = (const bf16*)(ws + (FOX ? WS_QA : WS_QB)); const bf16* Q2 = (const bf16*)(ws + WS_QB) + (size_t)T * 512;
    const bf16* K = (const bf16*)(ws + (FOX ? WS_KA : WS_KB)); const bf16* VT = (const bf16*)(ws + (FOX ? WS_VTA : WS_VTB));
    const float* Cc = (const float*)(ws + WS_C); bf16* O = (bf16*)(ws + WS_YA) + (FOX ? 0 : 512);
    constexpr int DQK = NDC * 16, PITCH = 8 * DQK, KS = FOX ? 176 : DQK * 2 + 16, VS = 144, KBYTES = 64 * KS, VBYTES = FOX ? 8192 : 64 * VS, VBASE = 2 * KBYTES, KCH = NDC * 2, NKC = 64 * KCH;
    constexpr float THR = 8.f, CUT = 48.f;
    int tid_ = threadIdx.x; asm volatile("" : "+v"(tid_));
    const int tid = tid_, lane = tid & 63, r32 = lane & 31, hi = lane >> 5, wid = __builtin_amdgcn_readfirstlane(tid >> 6);
    const int b = bh >> 3, h = bh & 7, q0 = qb * 256;
    const size_t rowbase = (size_t)b * S;
    const int NT = q0 / 64 + 4, ntw = (q0 + 32 * wid) / 64 + 1;
    const int kr0 = tid / KCH, kc0 = tid % KCH, kr1 = (tid + 512) / KCH, kc1 = (tid + 512) % KCH;
    const bool has2 = (NKC > 512) && (tid + 512 < NKC);
    const int kr1s = has2 ? kr1 : 0, kc1s = has2 ? kc1 : 0;
    const unsigned ko0 = (FOX || kc0 < 8) ? (unsigned)(((int)rowbase + kr0) * 512 + h * 64 + kc0 * 8) * 2u : (unsigned)(T * 512 + ((int)rowbase + kr0) * 32 + (kc0 - 8) * 8) * 2u;
    const unsigned ko1 = (kc1s < 8) ? (unsigned)(((int)rowbase + kr1s) * 512 + h * 64 + kc1s * 8) * 2u : (unsigned)(T * 512 + ((int)rowbase + kr1s) * 32 + (kc1s - 8) * 8) * 2u;
    const unsigned kst0 = (FOX || kc0 < 8) ? 64u * 512u * 2u : 64u * 32u * 2u, kst1 = (kc1s < 8) ? 64u * 512u * 2u : 64u * 32u * 2u;
    const int vr = tid >> 3, vc = tid & 7;
    const unsigned vo = FOX ? (unsigned)(((int)rowbase + vr) * 512 + h * 64 + vc * 8) * 2u : (unsigned)((bh * 64 + vr) * S + vc * 8) * 2u;
    const unsigned vst = FOX ? 64u * 512u * 2u : 128u;
    const float* cg_ = Cc + (size_t)bh * S;
    float cref = 0.f; if (FOX) cref = cg_[q0];
    const unsigned kl0 = kr0 * KS + kc0 * 16, kl1 = kr1 * KS + kc1 * 16, vl = FOX ? VBASE + (vc >> 2) * 4096 + (vr >> 4) * 1024 + (vr & 15) * 64 + (vc & 3) * 16 : VBASE + vr * VS + vc * 16, bl = tid * KS + 128;
#define ATT_GP(base, off) ((const __attribute__((address_space(1))) u32x4*)((const __attribute__((address_space(1))) unsigned char*)(base) + (off)))
    u32x4 kA0, kA1 = {0, 0, 0, 0}, vA, kB0, kB1 = {0, 0, 0, 0}, vB; float bA = 0.f, bB = 0.f;
#define ATT_LOAD(t, K0, K1, V, B) do { K0 = *ATT_GP(K, ko0 + (unsigned)(t) * kst0); if (has2) K1 = *ATT_GP(K, ko1 + (unsigned)(t) * kst1); V = *ATT_GP(VT, vo + (unsigned)(t) * vst); \
        if (FOX && tid < 64) B = (cref - ((const __attribute__((address_space(1))) float*)cg_)[(t) * 64 + tid]) * LOG2E; } while (0)
#define ATT_STORE(t, K0, K1, V, B) do { const unsigned bufo_ = ((t) & 1) * KBYTES; *(LAS u32x4*)(lds + bufo_ + kl0) = K0; if (has2) *(LAS u32x4*)(lds + bufo_ + kl1) = K1; \
        *(LAS u32x4*)(lds + ((t) & 1) * VBYTES + vl) = V; \
        if (FOX && tid < 64) { const unsigned h0 = bf1(B); const float r1 = B - bflo(h0); const unsigned h1 = bf1(r1); const float r2 = r1 - bflo(h1); const unsigned h2 = bf1(r2); \
            *(LAS u32x4*)(lds + bufo_ + bl) = (u32x4){h0 | (h1 << 16), h2 | 0x3F800000u, 0x3F803F80u, 0u}; } } while (0)
    const unsigned koff = r32 * KS + hi * 16, kaoff = r32 * KS + 128, voff = FOX ? VBASE + ((lane >> 4) & 1) * 32 + (lane & 3) * 8 + (4 * hi + ((lane & 15) >> 2)) * 64 : VBASE + r32 * VS + hi * 16;
    const unsigned one2_ = hi == 0 ? 0x3F803F80u : 0u;
    u32x4 qaug_w = {one2_, one2_ & 0xffffu, 0u, 0u};
    const s16x8 kaug_c = {0, 0, 0, (short)0x3F80, (short)0x3F80, (short)0x3F80, 0, 0};
#define ATT_SETM(mref) do { const float nm_ = -(mref); const unsigned h0 = bf1(nm_); const float r1 = nm_ - bflo(h0); const unsigned h1 = bf1(r1); const float r2 = r1 - bflo(h1); const unsigned h2 = bf1(r2); \
        qaug_w.y = hi == 0 ? ((one2_ & 0xffffu) | (h0 << 16)) : 0u; qaug_w.z = hi == 0 ? (h1 | (h2 << 16)) : 0u; } while (0)
    s16x8 qr[NDC];
    constexpr int NOPS = 2 * (NDC + 1);
#define ATT_KF(i, kb_) ((((i) >> 1) < NDC) ? *(const LAS s16x8*)(lds + (kb_) + koff + ((((i) >> 1) < NDC) ? ((i) >> 1) : 0) * 32 + ((i) & 1) * 32 * KS) \
                                            : (FOX ? *(const LAS s16x8*)(lds + (kb_) + kaoff + ((i) & 1) * 32 * KS) : kaug_c))
#define ATT_QKOP(i, N0, N1) do { constexpr int i_ = (i), d_ = i_ >> 1, blk_ = i_ & 1; if (i_ < NOPS) { \
        const s16x8 qf_ = d_ < NDC ? qr[d_ < NDC ? d_ : 0] : __builtin_bit_cast(s16x8, qaug_w); \
        if (blk_ == 0) N0 = __builtin_amdgcn_mfma_f32_32x32x16_bf16(ATT_KF(i_ < NOPS ? i_ : 0, kq_), qf_, d_ == 0 ? (f32x16){} : N0, 0, 0, 0); \
        else N1 = __builtin_amdgcn_mfma_f32_32x32x16_bf16(ATT_KF(i_ < NOPS ? i_ : 0, kq_), qf_, d_ == 0 ? (f32x16){} : N1, 0, 0, 0); } } while (0)
#define ATT_QK(N0, N1, t) do { const unsigned kq_ = ((t) & 1) * KBYTES; \
        ATT_QKOP(0, N0, N1); ATT_QKOP(1, N0, N1); ATT_QKOP(2, N0, N1); ATT_QKOP(3, N0, N1); ATT_QKOP(4, N0, N1); ATT_QKOP(5, N0, N1); ATT_QKOP(6, N0, N1); ATT_QKOP(7, N0, N1); \
        if (FOX) { ATT_QKOP(8, N0, N1); ATT_QKOP(9, N0, N1); } \
        else { ATT_QKOP(8, N0, N1); ATT_QKOP(9, N0, N1); ATT_QKOP(10, N0, N1); ATT_QKOP(11, N0, N1); \
               if (aug_on) { ATT_QKOP(12, N0, N1); ATT_QKOP(13, N0, N1); } } } while (0)
    ATT_LOAD(NT - 1, kA0, kA1, vA, bA);
    { const size_t qrow = rowbase + q0 + wid * 32 + r32;
      const bf16* qp = Q + qrow * 512 + h * 64 + hi * 8;
#pragma unroll
      for (int d0 = 0; d0 < 4; ++d0) qr[d0] = *(const s16x8*)(qp + d0 * 16);
      if (NDC > 4) { const bf16* qp2 = Q2 + qrow * 256 + h * 32 + hi * 8;
#pragma unroll
        for (int d0 = 4; d0 < NDC; ++d0) qr[d0] = *(const s16x8*)(qp2 + (d0 - 4) * 16); } }
    ATT_STORE(NT - 1, kA0, kA1, vA, bA);
    volatile LAS unsigned* vote = (volatile LAS unsigned*)(lds + 131072 + 128);
    if (FOX && lane < 2) vote[lane * 8 + wid] = 0u;
    ATT_LOAD(NT - 2, kB0, kB1, vB, bB);
    float m_ref = 0.f; f32x16 o0 = {}, o1 = {}; f32x2 lacc = {0.f, 0.f};
    bool aug_on = FOX;
    const int qabs = q0 + wid * 32 + r32;
    float qkb = 0.f;
    if (FOX) { float ssq = 0.f;
#pragma unroll
        for (int d0 = 0; d0 < 4; ++d0) { const u32x4 w = __builtin_bit_cast(u32x4, qr[d0]);
#pragma unroll
            for (int e = 0; e < 4; ++e) { const float a = bflo(w[e]), b = bfhi(w[e]); ssq += a * a + b * b; } }
        { auto rr = __builtin_amdgcn_permlane32_swap(__float_as_uint(ssq), __float_as_uint(ssq), false, false); ssq = __uint_as_float(rr[0]) + __uint_as_float(rr[1]); }
        const float kmax2 = __uint_as_float(((const unsigned*)(ws + WS_KMAX))[bh]);
        qkb = sqrtf(ssq * kmax2) * 1.001f + 0.01f; }
#define ATT_ROWMAX(rm, P0, P1) do { rm = max3f(P0[0], P0[1], P1[0]); \
        _Pragma("unroll") for (int r = 1; r < 16; ++r) rm = max3f(rm, P0[r], P1[r]); \
        rm = fmaxf(rm, P1[0]); rm = fmaxf(rm, P1[1]); \
        { auto rr = __builtin_amdgcn_permlane32_swap(__float_as_uint(rm), __float_as_uint(rm), false, false); rm = fmaxf(__uint_as_float(rr[0]), __uint_as_float(rr[1])); } } while (0)
#define ATT_EXPC(c, P) do { constexpr int o_ = ((c) & 1) * 8; \
        _Pragma("unroll") for (int r = 0; r < 8; ++r) P[o_ + r] = __builtin_amdgcn_exp2f(P[o_ + r]); \
        lacc += (f32x2){P[o_], P[o_ + 1]} + (f32x2){P[o_ + 2], P[o_ + 3]}; lacc += (f32x2){P[o_ + 4], P[o_ + 5]} + (f32x2){P[o_ + 6], P[o_ + 7]}; \
        u32x4 w; w.x = cvt_pk_bf16(P[o_], P[o_ + 1]); w.y = cvt_pk_bf16(P[o_ + 2], P[o_ + 3]); w.z = cvt_pk_bf16(P[o_ + 4], P[o_ + 5]); w.w = cvt_pk_bf16(P[o_ + 6], P[o_ + 7]); \
        pa[c] = __builtin_bit_cast(s16x8, w); } while (0)
#define ATT_EXPCD(c, P, dl_) do { constexpr int o_ = ((c) & 1) * 8; \
        _Pragma("unroll") for (int r = 0; r < 8; ++r) P[o_ + r] = __builtin_amdgcn_exp2f(P[o_ + r] - (dl_)); \
        lacc += (f32x2){P[o_], P[o_ + 1]} + (f32x2){P[o_ + 2], P[o_ + 3]}; lacc += (f32x2){P[o_ + 4], P[o_ + 5]} + (f32x2){P[o_ + 6], P[o_ + 7]}; \
        u32x4 w; w.x = cvt_pk_bf16(P[o_], P[o_ + 1]); w.y = cvt_pk_bf16(P[o_ + 2], P[o_ + 3]); w.z = cvt_pk_bf16(P[o_ + 4], P[o_ + 5]); w.w = cvt_pk_bf16(P[o_ + 6], P[o_ + 7]); \
        pa[c] = __builtin_bit_cast(s16x8, w); __builtin_amdgcn_sched_barrier(0); } while (0)
#define ATT_SOFTD(P0, P1, dl_) do { ATT_EXPCD(0, P0, dl_); ATT_EXPCD(1, P0, dl_); ATT_EXPCD(2, P1, dl_); ATT_EXPCD(3, P1, dl_); } while (0)
#define ATT_SOFT(P0, P1) do { ATT_EXPC(0, P0); ATT_EXPC(1, P0); ATT_EXPC(2, P1); ATT_EXPC(3, P1); } while (0)
#define ATT_VTR(p_) __builtin_bit_cast(s16x4, __builtin_amdgcn_ds_read_tr16_b64_v4i16((LAS v4i16_t*)(p_)))
#define ATT_VLOAD(t) do { const unsigned vb_ = ((t) & 1) * VBYTES; \
        if (FOX) { _Pragma("unroll") for (int g = 0; g < 4; ++g) _Pragma("unroll") for (int dh = 0; dh < 2; ++dh) { \
            const s16x4 lo_ = ATT_VTR(lds + vb_ + voff + dh * 4096 + g * 1024), hi_ = ATT_VTR(lds + vb_ + voff + dh * 4096 + g * 1024 + 512); \
            vf[2 * g + dh] = (s16x8){lo_[0], lo_[1], lo_[2], lo_[3], hi_[0], hi_[1], hi_[2], hi_[3]}; } } \
        else { _Pragma("unroll") for (int g = 0; g < 4; ++g) { vf[2 * g] = *(const LAS s16x8*)(lds + vb_ + voff + g * 32); vf[2 * g + 1] = *(const LAS s16x8*)(lds + vb_ + voff + 32 * VS + g * 32); } } } while (0)
#define ATT_PV() do { __builtin_amdgcn_sched_barrier(0); \
        _Pragma("unroll") for (int g = 0; g < 4; ++g) { \
            o0 = __builtin_amdgcn_mfma_f32_32x32x16_bf16(vf[2 * g], pa[g], o0, 0, 0, 0); \
            o1 = __builtin_amdgcn_mfma_f32_32x32x16_bf16(vf[2 * g + 1], pa[g], o1, 0, 0, 0); } } while (0)
#define ATT_STEP(t, LK0, LK1, LV, LB, SK0, SK1, SV, SB_) do { \
        asm volatile("s_waitcnt lgkmcnt(0)\n\ts_barrier" ::: "memory");     \
        if (FOX) { const u32x4 va_ = *(const volatile LAS u32x4*)(vote + (((t) + 1) & 1) * 8), vb_ = *(const volatile LAS u32x4*)(vote + (((t) + 1) & 1) * 8 + 4); \
            if ((va_.x & va_.y & va_.z & va_.w & vb_.x & vb_.y & vb_.z & vb_.w) != 0u) goto att_done; }     \
        if ((t) >= 2) ATT_LOAD((t) - 2, LK0, LK1, LV, LB); \
        if ((t) < ntw) { \
            s16x8 pa[4], vf[8]; float rm; f32x16 p0, p1; \
            if (FOX && (t) < ntw - 1 && __all(qkb + (cref - cg_[(t) * 64 + 63]) * LOG2E - m_ref < -CUT)) {     \
                if (lane == 0) vote[((t) & 1) * 8 + wid] = 1u; \
            } else { \
            ATT_QK(p0, p1, t); \
            if ((t) == ntw - 1) {                             \
                if (FOX) { int qa_ = qabs; asm volatile("" : "+v"(qa_)); const int kb = (t) * 64 + 4 * hi; \
                    _Pragma("unroll") for (int r = 0; r < 16; ++r) { const int kv = kb + (r & 3) + 8 * (r >> 2); if (kv > qa_) p0[r] = -1e30f; if (kv + 32 > qa_) p1[r] = -1e30f; } } \
                ATT_ROWMAX(rm, p0, p1); \
                if (FOX || __any(fabsf(rm) > THR)) { m_ref = rm; ATT_SETM(m_ref); aug_on = true; \
                    _Pragma("unroll") for (int r = 0; r < 16; ++r) { p0[r] -= rm; p1[r] -= rm; } \
                    ATT_SOFT(p0, p1); ATT_VLOAD(t); ATT_PV(); \
                } else { ATT_SOFT(p0, p1); ATT_VLOAD(t); ATT_PV(); }     \
            } else { \
                ATT_ROWMAX(rm, p0, p1); \
                if (FOX && __all(rm < -CUT)) {               \
                } else if (__builtin_expect(__any(rm > THR), 0)) { const float dl = fmaxf(rm, 0.f); m_ref += dl; ATT_SETM(m_ref); aug_on = true; \
                    const float al = __builtin_amdgcn_exp2f(-dl); o0 *= al; o1 *= al; lacc *= al; \
                    __builtin_amdgcn_sched_barrier(0); \
                    ATT_SOFTD(p0, p1, dl); ATT_VLOAD(t); ATT_PV(); \
                } else { ATT_SOFT(p0, p1); ATT_VLOAD(t); ATT_PV(); } \
            } \
            } \
        } \
        if ((t) >= 1) ATT_STORE((t) - 1, SK0, SK1, SV, SB_); } while (0)
    for (int t = NT - 1; t >= 1; t -= 2) {
        ATT_STEP(t, kA0, kA1, vA, bA, kB0, kB1, vB, bB);
        ATT_STEP(t - 1, kB0, kB1, vB, bB, kA0, kA1, vA, bA);
    }
att_done:
    asm volatile("s_waitcnt lgkmcnt(0)\n\ts_barrier" ::: "memory");
#undef ATT_ROWMAX
#undef ATT_QKOP
#undef ATT_EXPC
#undef ATT_SOFT
#undef ATT_SOFTD
#undef ATT_EXPCD
#undef ATT_VLOAD
#undef ATT_VTR
#undef ATT_PV
#undef ATT_KF
#undef ATT_STEP
#undef ATT_LOAD
#undef ATT_GP
#undef ATT_STORE
#undef ATT_QK
#undef ATT_SETM
    float l_ = lacc[0] + lacc[1];
    { auto rr = __builtin_amdgcn_permlane32_swap(__float_as_uint(l_), __float_as_uint(l_), false, false); l_ = __uint_as_float(rr[0]) + __uint_as_float(rr[1]); }
    const float inv = 1.f / l_;
    int lane_o = lane; asm volatile("" : "+v"(lane_o));
    bf16* op = O + (rowbase + q0 + wid * 32 + (lane_o & 31)) * 1024 + h * 64 + 4 * (lane_o >> 5);
#pragma unroll
    for (int i = 0; i < 4; ++i) {
        const f32x4 a = {o0[4 * i] * inv, o0[4 * i + 1] * inv, o0[4 * i + 2] * inv, o0[4 * i + 3] * inv};
        const f32x4 c = {o1[4 * i] * inv, o1[4 * i + 1] * inv, o1[4 * i + 2] * inv, o1[4 * i + 3] * inv};
        *(u32x2*)(op + 8 * i) = pack4(a); *(u32x2*)(op + 32 + 8 * i) = pack4(c);
    }
}
}

__device__ __forceinline__ float wave_sum(float v) {
#pragma unroll
    for (int o = 1; o < 64; o <<= 1) v += __shfl_xor(v, o);
    return v;
}
enum { MAP_ID = 0, MAP_IN, MAP_QUP, MAP_KVUP, MAP_GATE, MAP_UP };
__device__ __forceinline__ int map_row(int kind, int n) {
    switch (kind) {
        case MAP_IN:
            if (n < 1536) return n;
            if (n < 1544) return 1952 + (n - 1536);
            if (n < 1800) return 1536 + (n - 1544);
            if (n < 1928) return 1792 + (n - 1800);
            if (n < 1960) return 1920 + (n - 1928);
            return 2048 + (n - 1960);
        case MAP_QUP: { const int hh = n / 96, j = n % 96; return j < 64 ? hh * 64 + j : 512 + hh * 32 + (j - 64); }
        case MAP_KVUP: { const int hh = n >> 7, j = n & 127; return j < 64 ? hh * 64 + j : 512 + hh * 64 + (j - 64); }
        case MAP_GATE: return 256 * (n >> 7) + (n & 127);
        case MAP_UP: return 256 * (n >> 7) + 128 + (n & 127);
        default: return n;
    }
}
__device__ __forceinline__ void transpose_item(const float* W, int K, int N, bf16* WT, int kind, const float* gain, LAS float* scr, int item, int lane, int ldk = 0, int koff = 0) {
    if (ldk == 0) ldk = K;
    const int nblk = (N + 31) / 32, kb = item / nblk, nb = item % nblk, k0 = 64 * kb, n0 = 32 * nb;
    const int nl = n0 + (lane & 31);
#pragma unroll
    for (int i = 0; i < 32; ++i) { const int kk = 2 * i + (lane >> 5); float v = nl < N ? W[(size_t)(k0 + kk) * N + nl] : 0.f; if (gain) v *= gain[k0 + kk]; scr[kk * 33 + (lane & 31)] = v; }
    asm volatile("s_waitcnt lgkmcnt(0)" ::: "memory");
    const int c = lane & 7;
#pragma unroll
    for (int j = 0; j < 4; ++j) { const int n = (lane >> 3) + 8 * j; const LAS float* s = scr + (8 * c) * 33 + n;
        if (n0 + n < N) { u32x4 o; o.x = cvt_pk_bf16(s[0 * 33], s[1 * 33]); o.y = cvt_pk_bf16(s[2 * 33], s[3 * 33]); o.z = cvt_pk_bf16(s[4 * 33], s[5 * 33]); o.w = cvt_pk_bf16(s[6 * 33], s[7 * 33]);
            *(u32x4*)(WT + (size_t)map_row(kind, n0 + n) * ldk + koff + k0 + 8 * c) = o; } }
    asm volatile("s_waitcnt lgkmcnt(0)" ::: "memory");
}
__device__ __forceinline__ void cossin(double ang, float& c, float& s) {
    const double kd = __builtin_rint(ang * 0.6366197723675814);
    double r = __builtin_fma(-kd, 1.5707963267948966, ang); r = __builtin_fma(-kd, 6.123233995736766e-17, r);
    const int q = (int)kd & 3; const float x = (float)r, x2 = x * x;
    const float sn = x * (1.f + x2 * (-1.f / 6.f + x2 * (1.f / 120.f + x2 * (-1.f / 5040.f + x2 * (1.f / 362880.f)))));
    const float cs = 1.f + x2 * (-0.5f + x2 * (1.f / 24.f + x2 * (-1.f / 720.f + x2 * (1.f / 40320.f + x2 * (-1.f / 3628800.f)))));
    c = (q == 0) ? cs : (q == 1) ? -sn : (q == 2) ? -cs : sn;
    s = (q == 0) ? sn : (q == 1) ? cs : (q == 2) ? -sn : -cs;
}

#define XB_TMO      128
#define XB_XCNT(j)  (256  + 64 * (j))
#define XB_XSUB(j)  (1280 + 64 * (j))
#define XB_XGEN(j)  (2304 + 64 * (j))
#define XB_TOP      3328
#define XB_TOPGEN   3392
#define XCD_BAR_WORDS 3456
#define XB_SPIN_CAP (1u << 18)

__device__ __forceinline__ unsigned xb_ld(unsigned* p)              { return __hip_atomic_load(p, __ATOMIC_RELAXED, __HIP_MEMORY_SCOPE_AGENT); }
__device__ __forceinline__ unsigned xb_add(unsigned* p, unsigned v) { return __hip_atomic_fetch_add(p, v, __ATOMIC_RELAXED, __HIP_MEMORY_SCOPE_AGENT); }
__device__ __forceinline__ unsigned xb_xcc_id() { return (unsigned)__builtin_amdgcn_s_getreg((3 << 11) | 20) & 0xFu; }
#define XB_SPIN(cond, bar) do { unsigned _sp = 0; while (cond) { __builtin_amdgcn_s_sleep(1); \
    if ((++_sp & 255u) == 0u) { if (xb_ld(&(bar)[XB_TMO])) break; if (_sp > XB_SPIN_CAP) { atomicAdd(&(bar)[XB_TMO], 1u); break; } } } } while (0)

struct XcdBarrier {
    unsigned* bar; unsigned x;
    volatile LAS unsigned* st;
};

__device__ __forceinline__ XcdBarrier xcd_barrier_post(unsigned* bar, volatile LAS unsigned* st) {
    XcdBarrier b; b.bar = bar; b.x = xb_xcc_id(); b.st = st;
    if (threadIdx.x == 0) (void)xb_add(&bar[XB_XCNT(b.x)], 1u);
    return b;
}
__device__ __forceinline__ void xcd_barrier_complete(unsigned* bar, unsigned x, unsigned& nloc, unsigned& nx) {
    const unsigned G = gridDim.x * gridDim.y * gridDim.z;
    unsigned sum, cnt, mine, sp = 0u;
    for (;;) {
        sum = 0u; cnt = 0u; mine = 0u;
#pragma unroll
        for (unsigned j = 0; j < 16; ++j) { const unsigned c = xb_ld(&bar[XB_XCNT(j)]); sum += c; cnt += (c > 0u) ? 1u : 0u; mine = (j == x) ? c : mine; }
        if (sum == G) break;
        __builtin_amdgcn_s_sleep(1);
        if ((++sp & 255u) == 0u) { if (xb_ld(&bar[XB_TMO])) break; if (sp > XB_SPIN_CAP) { atomicAdd(&bar[XB_TMO], 1u); break; } }
    }
    nloc = mine > 0u ? mine : 1u; nx = cnt > 0u ? cnt : 1u;
}

__device__ __forceinline__ void xcd_barrier(const XcdBarrier& b) {
    asm volatile("s_waitcnt vmcnt(0)" ::: "memory");
    __syncthreads();
    if (threadIdx.x == 0) {
        unsigned* bar = b.bar;
        __builtin_amdgcn_s_waitcnt(0);
        unsigned nloc = b.st[0], nx = b.st[1];
        if (nloc == 0u) { xcd_barrier_complete(bar, b.x, nloc, nx); b.st[0] = nloc; b.st[1] = nx; }
        const unsigned old = xb_add(&bar[XB_XSUB(b.x)], 1u);
        const unsigned gen = old / nloc;
        if (old + 1u == (gen + 1u) * nloc) {
            __builtin_amdgcn_fence(__ATOMIC_RELEASE, "agent");
            asm volatile("s_waitcnt vmcnt(0)" ::: "memory");
            const unsigned og = xb_add(&bar[XB_TOP], 1u);
            const unsigned tg = og / nx;
            if (og + 1u == (tg + 1u) * nx) xb_add(&bar[XB_TOPGEN], 1u);
            else XB_SPIN(xb_ld(&bar[XB_TOPGEN]) == tg, bar);
            __builtin_amdgcn_fence(__ATOMIC_ACQUIRE, "agent");
            xb_add(&bar[XB_XGEN(b.x)], 1u);
            asm volatile("s_waitcnt vmcnt(0)" ::: "memory");
        } else {
            XB_SPIN(xb_ld(&bar[XB_XGEN(b.x)]) == gen, bar);
            __builtin_amdgcn_fence(__ATOMIC_ACQUIRE, "agent");
            asm volatile("s_waitcnt vmcnt(0)" ::: "memory");
        }
    }
    __syncthreads();
}

struct Args { const float* in[18]; float* out; unsigned char* ws; int ph_lo, ph_hi; };
enum { I_X = 0, I_POS, I_GMIX, I_WIN, I_BF, I_GQ, I_WQUP, I_GKV, I_WKVUP, I_WA, I_WB, I_BG, I_WOUT, I_GFFN, I_WG, I_WU, I_WD, I_GFIN };
constexpr int N_PHASES = 9;

template <class Epi> __device__ __forceinline__ void run_gemm(LAS unsigned char* lds, const bf16* A, const bf16* Bt, int M, int N, int K, int G, const Epi& E) {
    pg8::Gemm g{A, Bt, M, N, K}; pg8::StaticOrder So; So.init(M, N, G, (int)blockIdx.x);
    pg8::gemm_phase<Epi, pg8::StaticOrder, true, true>(lds, g, So, E);
}


#define P_(T_, off) ((T_*)(args.ws + (off)))
#define Win_t P_(bf16, WS_WIN)
#define Wq_t P_(bf16, WS_WQ)
#define Wkv_t P_(bf16, WS_WKV)
#define Wa_t P_(bf16, WS_WA)
#define Wb_t P_(bf16, WS_WB)
#define Wout_t P_(bf16, WS_WOUT)
#define Wgu_t P_(bf16, WS_WGU)
#define Wdn_t P_(bf16, WS_WDN)
#define KR P_(float, WS_KR)
#define LOGF P_(float, WS_LOGF)
#define CC P_(float, WS_C)
#define PSQ P_(float, WS_PSQ)
#define PSKV P_(float, WS_PSKV)
#define CS P_(float, WS_CS)
#define PSH P_(float, WS_PSH)
#define XN P_(bf16, WS_XN)
#define YA P_(bf16, WS_YA)
#define YB P_(bf16, WS_YB)
#define QA P_(bf16, WS_QA)
#define KA P_(bf16, WS_KA)
#define VTA P_(bf16, WS_VTA)
#define MG P_(bf16, WS_MERGED)
#define CQ P_(bf16, WS_CQ)
#define CKV P_(bf16, WS_CKV)
#define GA P_(bf16, WS_GA)
#define GB P_(bf16, WS_GB)
#define QB P_(bf16, WS_QB)
#define KB P_(bf16, WS_KB)
#define VTB P_(bf16, WS_VTB)
#define HB P_(bf16, WS_HB)
#define H2B P_(bf16, WS_H2B)
#define ACT P_(bf16, WS_ACT)
__global__ void __launch_bounds__(NTHREADS, 2) mega_fwd(Args args) {
    __builtin_assume(__builtin_amdgcn_workitem_id_y() == 0); __builtin_assume(__builtin_amdgcn_workitem_id_z() == 0);
    extern __shared__ __attribute__((aligned(16))) unsigned char lds_raw[];
    LAS unsigned char* lds = (LAS unsigned char*)lds_raw;
    cg::grid_group grid = cg::this_grid();
    const int wave = __builtin_amdgcn_readfirstlane((int)threadIdx.x >> 6);
    const int G = gridDim.x, bx = blockIdx.x, vcu = (G % 8 == 0) ? (bx % 8) * (G / 8) + bx / 8 : bx;
#define TID_INIT int tid = threadIdx.x; asm volatile("" : "+v"(tid)); const int lane = tid & 63, gt = bx * NTHREADS + tid; (void)lane; (void)gt
    const int lo = args.ph_lo, hi_ = args.ph_hi;
    volatile LAS unsigned* bar_st = (volatile LAS unsigned*)(lds + 131072 + 64);
    if (threadIdx.x < 2) bar_st[threadIdx.x] = 0u;
    __syncthreads();
    XcdBarrier xbar = xcd_barrier_post((unsigned*)args.ws, bar_st);
#ifdef ONLY_PHASE
#define IN(k) ((k) == ONLY_PHASE)
#else
#define IN(k) (lo <= (k) && (k) < hi_)
#endif
    if (lo < 0) grid.sync();
#define SEAM(k) do { if (IN(k) && IN((k) + 1)) xcd_barrier(xbar); } while (0)
    const int gw = vcu * NWAVES + wave, NGW = G * NWAVES;
    const int NGT = G * NTHREADS;

    if (IN(0)) { TID_INIT;
        LAS float* scr = (LAS float*)(lds + wave * 16384);
        constexpr int I_IN = 16 * 126, I_Q = 4 * 24, I_KV = 2 * 32, I_AB = 8 * 32, I_O = 16 * 32, I_GU = 16 * 88, I_D = 44 * 32;
        constexpr int NIT = I_IN + I_Q + I_KV + 2 * I_AB + I_O + 2 * I_GU + I_D;
        for (int it = gw; it < NIT; it += NGW) {
            int r = it;
            if (r < I_IN) { transpose_item(args.in[I_WIN], DM, IN_W, Win_t, MAP_IN, nullptr, scr, r, lane); continue; } r -= I_IN;
            if (r < I_Q) { transpose_item(args.in[I_WQUP], 256, 768, Wq_t, MAP_QUP, args.in[I_GQ], scr, r, lane); continue; } r -= I_Q;
            if (r < I_KV) { transpose_item(args.in[I_WKVUP], 128, 1024, Wkv_t, MAP_KVUP, args.in[I_GKV], scr, r, lane); continue; } r -= I_KV;
            if (r < I_AB) { transpose_item(args.in[I_WA], 512, DM, Wa_t, MAP_ID, nullptr, scr, r, lane, 1024, 0); continue; } r -= I_AB;
            if (r < I_AB) { transpose_item(args.in[I_WB], 512, DM, Wa_t, MAP_ID, nullptr, scr, r, lane, 1024, 512); continue; } r -= I_AB;
            if (r < I_O) { transpose_item(args.in[I_WOUT], DM, DM, Wout_t, MAP_ID, nullptr, scr, r, lane); continue; } r -= I_O;
            if (r < I_GU) { transpose_item(args.in[I_WG], DM, FFN, Wgu_t, MAP_GATE, args.in[I_GFFN], scr, r, lane); continue; } r -= I_GU;
            if (r < I_GU) { transpose_item(args.in[I_WU], DM, FFN, Wgu_t, MAP_UP, args.in[I_GFFN], scr, r, lane); continue; } r -= I_GU;
            transpose_item(args.in[I_WD], FFN, DM, Wdn_t, MAP_ID, nullptr, scr, r, lane);
        }
        if (gt < 32) ((unsigned*)(args.ws + WS_KMAX))[gt] = 0u;
        for (int i = gt; i < 88 * DM / 8; i += NGT) *(u32x4*)(Win_t + (size_t)1960 * DM + (size_t)i * 8) = (u32x4){0u, 0u, 0u, 0u};
        { const float* gm = args.in[I_GMIX]; f32x4 gv[4];
#pragma unroll
          for (int j = 0; j < 4; ++j) gv[j] = *(const f32x4*)(gm + 4 * lane + 256 * j);
          for (int mrow = gw; mrow < T; mrow += 4 * NGW) {
            f32x4 v[4][4]; float ss[4];
#pragma unroll
            for (int q = 0; q < 4; ++q) { const f32x4* xr = (const f32x4*)(args.in[I_X] + (size_t)(mrow + q * NGW) * DM) + lane;
#pragma unroll
              for (int j = 0; j < 4; ++j) v[q][j] = xr[64 * j]; }
#pragma unroll
            for (int q = 0; q < 4; ++q) { float s = 0.f;
#pragma unroll
              for (int j = 0; j < 4; ++j) s += sumsq4(v[q][j]);
              ss[q] = s; }
#pragma unroll
            for (int o = 1; o < 64; o <<= 1) {
#pragma unroll
              for (int q = 0; q < 4; ++q) ss[q] += __shfl_xor(ss[q], o); }
#pragma unroll
            for (int q = 0; q < 4; ++q) { const float rstd = rsqrtf(ss[q] * (1.f / DM) + EPS);
#pragma unroll
              for (int j = 0; j < 4; ++j) *(u32x2*)(XN + (size_t)(mrow + q * NGW) * DM + 4 * lane + 256 * j) = pack4(v[q][j] * rstd * gv[j]); }
          } }
        { const int* pos = (const int*)args.in[I_POS];
          constexpr double IF[16] = {1.0, 0.5623413251903491, 0.31622776601683794, 0.1778279410038923, 0.1, 0.05623413251903491, 0.03162277660168379, 0.01778279410038923,
                                     0.01, 0.005623413251903491, 0.0031622776601683794, 0.0017782794100389228, 0.001, 0.0005623413251903491, 0.00031622776601683794, 0.00017782794100389227};
          for (int t = gt; t < T; t += NGT) { const double p = (double)pos[t];
#pragma unroll
            for (int j = 0; j < 16; j += 2) { float c0, s0, c1, s1; cossin(p * IF[j], c0, s0); cossin(p * IF[j + 1], c1, s1); *(f32x4*)(CS + (size_t)t * 32 + 2 * j) = (f32x4){c0, s0, c1, s1}; } } }
    }
    SEAM(0);
    if (IN(1)) {
        EpiIn E{args.ws, args.in[I_BF], args.in[I_BG]};
#if defined(DUP_PHASE) && DUP_PHASE == 1
        run_gemm(lds, XN, Win_t, T, IN_WP, DM, G, E);
#endif
        run_gemm(lds, XN, Win_t, T, IN_WP, DM, G, E);
    }
    SEAM(1);
    if (IN(2)) { TID_INIT;
        LAS double* sw = (LAS double*)lds;
        for (int j = vcu; j < NB * NH; j += G) {
            const int b = j >> 3, h = j & 7; const float* src = LOGF + ((size_t)b * S + tid * 16) * 8 + h;
            double v[16]; double run = 0.0;
#pragma unroll
            for (int i = 0; i < 16; ++i) { run += (double)src[i * 8]; v[i] = run; }
            double xs = run;
#pragma unroll
            for (int o = 1; o < 64; o <<= 1) { const double y = __shfl_up(xs, o); if (lane >= o) xs += y; }
            if (lane == 63) sw[wave] = xs;
            __syncthreads();
            double base = 0.0;
            for (int w = 0; w < wave; ++w) base += sw[w];
            const double excl = base + xs - run;
            float* dst = CC + (size_t)j * S + tid * 16;
#pragma unroll
            for (int i = 0; i < 16; i += 4) *(f32x4*)(dst + i) = (f32x4){(float)(excl + v[i]), (float)(excl + v[i + 1]), (float)(excl + v[i + 2]), (float)(excl + v[i + 3])};
            __syncthreads();
        }
        for (int idx = gt; idx < T * 8; idx += NGT) {
            const int hh = idx >> 15, t = idx & (T - 1); const u32x4* kp = (const u32x4*)(KA + (size_t)t * 512 + hh * 64); float ssq = 0.f;
#pragma unroll
            for (int c8 = 0; c8 < 8; ++c8) { const u32x4 w = kp[c8];
#pragma unroll
                for (int e = 0; e < 4; ++e) { const float a = bflo(w[e]), b = bfhi(w[e]); ssq += a * a + b * b; } }
#pragma unroll
            for (int o = 1; o < 64; o <<= 1) ssq = fmaxf(ssq, __shfl_xor(ssq, o));
            if (lane == 0) atomicMax((unsigned*)(args.ws + WS_KMAX) + ((t >> 13) * 8 + hh), __float_as_uint(ssq));
        }
        { bf16* KR2 = KB + (size_t)T * 512;
          for (int idx = gt; idx < T * 4; idx += NGT) {
            const int t = idx >> 2, g4 = idx & 3; const f32x4* kr = (const f32x4*)(KR + (size_t)t * 32); const f32x4* cs = (const f32x4*)(CS + (size_t)t * 32);
            const f32x4 x1 = kr[g4], x2 = kr[4 + g4], ca = cs[2 * g4], cb = cs[2 * g4 + 1];
            const f32x4 c = {ca[0], ca[2], cb[0], cb[2]}, sn = {ca[1], ca[3], cb[1], cb[3]};
            *(u32x2*)(KR2 + (size_t)t * 32 + 4 * g4) = pack4(x1 * c - x2 * sn); *(u32x2*)(KR2 + (size_t)t * 32 + 16 + 4 * g4) = pack4(x2 * c + x1 * sn);
          } }
        __syncthreads();
#if !defined(P2_PART) || P2_PART == 1
        { EpiQup E{QB, QB + (size_t)T * 512, PSQ, CS}; run_gemm(lds, CQ, Wq_t, T, 768, 256, G, E); }
#endif
#if !defined(P2_PART) || P2_PART == 2
        { EpiKVup E{KB, VTB, PSKV}; run_gemm(lds, CKV, Wkv_t, T, 1024, 128, G, E); }
#endif
    }
    SEAM(2);
    if (IN(3)) {
#ifdef DUP_P3
      for (int rep_ = 0; rep_ < 2; ++rep_) {
#endif
#define ATT_UNITS(CALL) do { \
        if (G == 256) { const int xcd_ = vcu >> 5, c_ = vcu & 31; \
            for (int r_ = 0; r_ < 4; ++r_) { const int bh = xcd_ * 4 + r_, c2_ = (c_ + 16) & 31; const int qb = r_ == 0 ? c_ : r_ == 1 ? 31 - c_ : r_ == 2 ? c2_ : 31 - c2_; CALL; } } \
        else { for (int i = vcu; i < 1024; i += G) { const int bh = (i & 255) >> 3, s_ = i & 7, rd = i >> 8; const int qb = rd == 0 ? s_ : rd == 1 ? 15 - s_ : rd == 2 ? 16 + s_ : 31 - s_; CALL; } } } while (0)
        ATT_UNITS((att::attn_unit<4, true>(lds, args.ws, bh, qb)));
        __syncthreads();
        ATT_UNITS((att::attn_unit<6, false>(lds, args.ws, bh, qb)));
#undef ATT_UNITS
        __syncthreads();
#ifdef DUP_P3
      }
#endif
    }
    SEAM(3);
    if (IN(4)) {
        { EpiMerge E{GA, GB, MG}; run_gemm(lds, YA, Wa_t, T, DM, 1024, G, E); }
    }
    SEAM(4);
    if (IN(5)) { EpiOut E{args.in[I_X], HB, PSH}; run_gemm(lds, MG, Wout_t, T, DM, DM, G, E); }
    SEAM(5);
    if (IN(6)) { EpiGU E{PSH, ACT};
#if defined(DUP_PHASE) && DUP_PHASE == 6
        run_gemm(lds, HB, Wgu_t, T, 2 * FFN, DM, G, E);
#endif
        run_gemm(lds, HB, Wgu_t, T, 2 * FFN, DM, G, E); }
    SEAM(6);
    if (IN(7)) { EpiDown E{HB, H2B, PSH}; run_gemm(lds, ACT, Wdn_t, T, DM, FFN, G, E); }
    SEAM(7);
    if (IN(8)) { TID_INIT;
        const float* gm = args.in[I_GFIN]; f32x4 gv[4];
#pragma unroll
        for (int j = 0; j < 4; ++j) gv[j] = *(const f32x4*)(gm + 4 * lane + 256 * j);
        for (int mrow = gw; mrow < T; mrow += 4 * NGW) {
            u32x2 v[4][4]; float ss[4];
#pragma unroll
            for (int q = 0; q < 4; ++q) { const int row = mrow + q * NGW; const u32x2* hr = (const u32x2*)(H2B + (size_t)row * DM) + lane;
#pragma unroll
              for (int j = 0; j < 4; ++j) v[q][j] = hr[64 * j];
              const f32x4* pp = (const f32x4*)(PSH + (size_t)row * 4); const f32x4 pt = (pp[0] + pp[T]) + (pp[2 * T] + pp[3 * T]);
              ss[q] = (pt[0] + pt[1]) + (pt[2] + pt[3]); }
#pragma unroll
            for (int q = 0; q < 4; ++q) { const float rstd = rsqrtf(ss[q] * (1.f / DM) + EPS); f32x4* xw = (f32x4*)(args.out + (size_t)(mrow + q * NGW) * DM) + lane;
#pragma unroll
              for (int j = 0; j < 4; ++j) { const f32x4 hv = {bflo(v[q][j].x), bfhi(v[q][j].x), bflo(v[q][j].y), bfhi(v[q][j].y)}; xw[64 * j] = hv * rstd * gv[j]; } }
        }
    }
#undef IN
#undef SEAM
}

#ifdef DBG_STOP
#ifndef DBG_N
#define DBG_N (T * DM)
#endif
__global__ void dbg_dump(const unsigned short* src, float* dst, int n) {
    for (int i = blockIdx.x * blockDim.x + threadIdx.x; i < n; i += gridDim.x * blockDim.x) dst[i] = i < DBG_N ? __uint_as_float((unsigned)src[i] << 16) : 0.f;
}
#endif
#ifndef MK_COOP
#define MK_COOP 1
#endif
extern "C" void kernel_launch(void* const* d_in, const int* in_sizes, int n_in, void* d_out, int out_size, void* d_ws, size_t ws_size, hipStream_t stream) {
    static int grid = 0;
    if (grid == 0) {
        if (n_in != 18 || in_sizes[0] != T * DM || out_size != T * DM || ws_size < WS_END) { fprintf(stderr, "kernel_launch: unexpected shapes (n_in %d, in0 %d, out %d, ws %zu)\n", n_in, n_in > 0 ? in_sizes[0] : -1, out_size, ws_size); grid = -1; return; }
        int dev = 0, cus = 0, per_cu = 0;
        if (hipGetDevice(&dev) != hipSuccess || hipDeviceGetAttribute(&cus, hipDeviceAttributeMultiprocessorCount, dev) != hipSuccess) { grid = -1; return; }
        if (hipFuncSetAttribute((const void*)mega_fwd, hipFuncAttributeMaxDynamicSharedMemorySize, LDS_BYTES) != hipSuccess) { fprintf(stderr, "kernel_launch: hipFuncSetAttribute failed\n"); grid = -1; return; }
        if (hipOccupancyMaxActiveBlocksPerMultiprocessor(&per_cu, (const void*)mega_fwd, NTHREADS, LDS_BYTES) != hipSuccess || per_cu < 1) { fprintf(stderr, "kernel_launch: occupancy query says %d\n", per_cu); per_cu = 1; }
        (void)hipGetLastError();
        grid = cus * 1;
    }
    if (grid < 0) return;
    Args a{};
    for (int i = 0; i < 18; ++i) a.in[i] = (const float*)d_in[i];
    a.out = (float*)d_out; a.ws = (unsigned char*)d_ws;
#if MK_COOP
    a.ph_lo = 0; a.ph_hi = N_PHASES;
    if (hipMemsetAsync(d_ws, 0, 16384, stream) != hipSuccess) { fprintf(stderr, "kernel_launch: memset of the barrier words failed\n"); return; }
    void* kargs[] = {&a};
    hipError_t e = hipLaunchCooperativeKernel((const void*)mega_fwd, dim3(grid), dim3(NTHREADS), kargs, LDS_BYTES, stream);
    if (e != hipSuccess) fprintf(stderr, "cooperative launch failed: %s (grid %d)\n", hipGetErrorString(e), grid);
#else
#ifdef DBG_STOP
    for (int p = 0; p <= DBG_STOP; ++p) { a.ph_lo = p; a.ph_hi = p + 1; hipLaunchKernelGGL(mega_fwd, dim3(grid), dim3(NTHREADS), LDS_BYTES, stream, a); }
#ifndef DBG_NO_DUMP
    hipLaunchKernelGGL(dbg_dump, dim3(2048), dim3(256), 0, stream, (const unsigned short*)((unsigned char*)d_ws + (size_t)DBG_OFF * MiB), (float*)d_out, T * DM);
#endif
#else
    for (int p = 0; p < N_PHASES; ++p) { a.ph_lo = p; a.ph_hi = p + 1; hipLaunchKernelGGL(mega_fwd, dim3(grid), dim3(NTHREADS), LDS_BYTES, stream, a); }
#endif
#endif
}
```

```cpp
#include <hip/hip_runtime.h>
#include <hip/hip_cooperative_groups.h>
#include <cstdio>
#include <cstdint>
namespace cg = cooperative_groups;
namespace pg8 {
#define PG8_LAS __attribute__((address_space(3)))
typedef unsigned short bf16_t;
typedef short bf16x8 __attribute__((ext_vector_type(8)));
typedef float f32x4 __attribute__((ext_vector_type(4)));
typedef unsigned u32x4 __attribute__((ext_vector_type(4)));
constexpr int BM = 256, BK = 64, HALF = 128, HTB = HALF * BK * 2  , STAGE_BYTES = 8 * HTB, NXCD = 8, WGM = 8;

__host__ __device__ __forceinline__ int lds_byte(int r, int c) { const int st = (r >> 4) * 2 + (c >> 5), rr = r & 15, cc = c & 31, ob = rr * 64 + cc * 2; return st * 1024 + (ob ^ (((ob >> 9) & 1) << 5)); }
__host__ __device__ __forceinline__ void stage_rc(int b, int& R, int& C) { const int st = b / 1024, sb = b % 1024, swz = sb ^ (((sb >> 9) & 1) << 5); R = (st >> 1) * 16 + swz / 64; C = (st & 1) * 32 + (swz % 64) / 2; }
__host__ __device__ __forceinline__ int perm32(int rho) { const int n = rho >> 4, i = rho & 15; return 8 * (i >> 2) + 4 * n + (i & 3); }

struct Unit { int pm, pn; };
struct Gemm { const bf16_t* A; const bf16_t* Bt; int M, N, K; };

struct StaticOrder {
    int nM, nN, nwg, G, c;
    __host__ __device__ void init(int M, int N, int G_, int c_) { nM = M / BM; nN = N / BM; nwg = nM * nN; G = G_; c = c_; }
    __host__ __device__ bool next(int i, Unit& u) const {
        const long L = (long)i * G + c; if (L >= nwg) return false;
        int wgid = (int)L; { const int q = nwg / NXCD, r = nwg % NXCD, xcd = wgid % NXCD, off = wgid / NXCD; wgid = (xcd < r ? xcd * (q + 1) : r * (q + 1) + (xcd - r) * q) + off; }
        const int nig = WGM * nN, gid = wgid / nig, fm = gid * WGM, gsz = (nM - fm) < WGM ? (nM - fm) : WGM;
        u.pm = fm + ((wgid % nig) % gsz); u.pn = (wgid % nig) / gsz; return true;
    }
    __device__ __forceinline__ void a_ready(const Unit&) const {}
    __device__ __forceinline__ void done(const Unit&) const {}
};

typedef float f32x2c __attribute__((ext_vector_type(2))); typedef __bf16 bf16x2c __attribute__((ext_vector_type(2)));
__device__ __forceinline__ unsigned cvt_pk_bf16(float lo, float hi) { const f32x2c v = {lo, hi}; const bf16x2c b = __builtin_convertvector(v, bf16x2c); return __builtin_bit_cast(unsigned, b); }
template <class Epi, class Sched, bool ALIGN_EPI = false, bool SP2 = false>
__device__ __forceinline__ void gemm_phase(PG8_LAS unsigned char* lds, const Gemm g, const Sched& S, const Epi& E) {
    int tid_ = threadIdx.x; asm volatile("" : "+v"(tid_));
    const int tid = tid_, wid = __builtin_amdgcn_readfirstlane(tid >> 6), lane = tid & 63, wr = wid >> 2, wc = wid & 3, fr = lane & 15, fq = lane >> 4;
    const int K = g.K, nt = K / BK;
    unsigned voffA[2], voffB[2];
#pragma unroll
    for (int i = 0; i < 2; ++i) { int R, C; stage_rc(tid * 16 + i * 8192, R, C); const int Rb = Epi::PERM ? ((R & ~31) + perm32(R & 31)) : R;
        voffA[i] = (unsigned)(R * K + C) * 2u; voffB[i] = (unsigned)(Rb * K + C) * 2u; }
    const size_t kstep = (size_t)(BK * 2);
    const size_t hstep = (size_t)HALF * K * 2;
    const size_t tstep = 2 * hstep;
    const unsigned ldsw = (unsigned)wid * 1024u;
    const int aoff = lds_byte(wr * 64 + fr, fq * 8), boff = lds_byte(wc * 32 + fr, fq * 8);
#define PG8_SA(b, h) (((b) * 2 + (h)) * HTB)
#define PG8_SB(b, h) ((4 + (b) * 2 + (h)) * HTB)
#define PG8_STAGE(bufoff, gbase, voff) do { _Pragma("unroll") for (int _i = 0; _i < 2; ++_i) \
        __builtin_amdgcn_global_load_lds((const unsigned*)((const char*)(gbase) + (voff)[_i]), (PG8_LAS unsigned*)(lds + (bufoff) + ldsw + _i * 8192), 16, 0, 0); } while (0)
#define PG8_LDA(dst, b, h) do { _Pragma("unroll") for (int m = 0; m < 4; ++m) _Pragma("unroll") for (int k = 0; k < 2; ++k) dst[m][k] = *(const PG8_LAS bf16x8*)(lds + PG8_SA(b, h) + aoff + m * 2048 + k * 1024); } while (0)
#define PG8_LDB(dst, b, h) do { _Pragma("unroll") for (int n = 0; n < 2; ++n) _Pragma("unroll") for (int k = 0; k < 2; ++k) dst[n][k] = *(const PG8_LAS bf16x8*)(lds + PG8_SB(b, h) + boff + n * 2048 + k * 1024); } while (0)
#define PG8_MMA(ai, bj, At, Bt) do { __builtin_amdgcn_s_setprio(1); _Pragma("unroll") for (int m = 0; m < 4; ++m) _Pragma("unroll") for (int n = 0; n < 2; ++n) _Pragma("unroll") for (int k = 0; k < 2; ++k) \
        acc[ai][bj][m][n] = __builtin_amdgcn_mfma_f32_16x16x32_bf16(Bt[n][k], At[m][k], acc[ai][bj][m][n], 0, 0, 0); __builtin_amdgcn_s_setprio(0); } while (0)
#define PG8_WAIT_V(n) asm volatile("s_waitcnt vmcnt(" #n ")" ::: "memory")
#define PG8_WAIT_L(n) asm volatile("s_waitcnt lgkmcnt(" #n ")" ::: "memory")
#define PG8_BAR __builtin_amdgcn_s_barrier()
#define PG8_SCHED __builtin_amdgcn_sched_barrier(0)
    Unit cur, nxt; int ui = 0;
    if (!S.next(0, cur)) return;
    f32x4 acc[2][2][4][2];
#pragma unroll
    for (int a = 0; a < 2; ++a)
#pragma unroll
        for (int b = 0; b < 2; ++b)
#pragma unroll
            for (int m = 0; m < 4; ++m)
#pragma unroll
                for (int n = 0; n < 2; ++n) acc[a][b][m][n] = (f32x4){0.f, 0.f, 0.f, 0.f};
    bf16x8 At[4][2], B0[2][2], B1[2][2];
    const char* cA = (const char*)g.A + (size_t)cur.pm * tstep; const char* cB = (const char*)g.Bt + (size_t)cur.pn * tstep;
    S.a_ready(cur);
    if constexpr (SP2) {
        PG8_STAGE(PG8_SB(0, 0), cB, voffB); PG8_STAGE(PG8_SB(0, 1), cB + hstep, voffB); PG8_STAGE(PG8_SA(0, 0), cA, voffA); PG8_STAGE(PG8_SA(0, 1), cA + hstep, voffA);
        if (wr == 1) PG8_BAR;
        PG8_WAIT_V(2); PG8_BAR;
        PG8_STAGE(PG8_SB(1, 0), cB + kstep, voffB); PG8_STAGE(PG8_SA(1, 0), cA + kstep, voffA); PG8_STAGE(PG8_SB(1, 1), cB + hstep + kstep, voffB);
        PG8_WAIT_V(6); PG8_BAR;
    } else {
        PG8_STAGE(PG8_SB(0, 0), cB, voffB); PG8_STAGE(PG8_SA(0, 0), cA, voffA); PG8_STAGE(PG8_SB(0, 1), cB + hstep, voffB); PG8_STAGE(PG8_SA(0, 1), cA + hstep, voffA);
        if (wr == 1) PG8_BAR;
        PG8_WAIT_V(4); PG8_BAR;
        PG8_STAGE(PG8_SB(1, 0), cB + kstep, voffB); PG8_STAGE(PG8_SA(1, 0), cA + kstep, voffA); PG8_STAGE(PG8_SB(1, 1), cB + hstep + kstep, voffB);
        PG8_WAIT_V(6); PG8_BAR;
    }
    for (;;) {
        const bool has_next = S.next(ui + 1, nxt);
        const char* nA = has_next ? (const char*)g.A + (size_t)nxt.pm * tstep : cA; const char* nB = has_next ? (const char*)g.Bt + (size_t)nxt.pn * tstep : cB;
        for (int t = 0; t < nt; t += 2) {
            if constexpr (Epi::HAS_MID) { if (t == (nt >> 1)) E.mid(acc, cur, wr, wc, fr, fq); }
            const bool last = (t == nt - 2);
            const char* a1 = cA + (size_t)(t + 1) * kstep;
            const char* a2 = last ? nA : cA + (size_t)(t + 2) * kstep; const char* b2 = last ? nB : cB + (size_t)(t + 2) * kstep;
            const char* a3 = a2 + kstep; const char* b3 = b2 + kstep;
            if (last && has_next) S.a_ready(nxt);
            if constexpr (SP2) {
            PG8_LDB(B0, 0, 0); PG8_LDB(B1, 0, 1); PG8_SCHED; PG8_LDA(At, 0, 0); PG8_STAGE(PG8_SA(1, 1), a1 + hstep, voffA);
            PG8_WAIT_V(8); PG8_WAIT_L(0); PG8_BAR; PG8_MMA(0, 0, At, B0); PG8_MMA(0, 1, At, B1); PG8_BAR; PG8_SCHED;
            PG8_LDA(At, 0, 1); PG8_STAGE(PG8_SB(0, 0), b2, voffB); PG8_STAGE(PG8_SB(0, 1), b2 + hstep, voffB); PG8_STAGE(PG8_SA(0, 0), a2, voffA);
            PG8_WAIT_V(8); PG8_WAIT_L(0); PG8_BAR; PG8_MMA(1, 0, At, B0); PG8_MMA(1, 1, At, B1); PG8_BAR; PG8_SCHED;
            PG8_LDB(B0, 1, 0); PG8_LDB(B1, 1, 1); PG8_SCHED; PG8_LDA(At, 1, 0); PG8_STAGE(PG8_SA(0, 1), a2 + hstep, voffA);
            PG8_WAIT_V(8); PG8_WAIT_L(0); PG8_BAR; PG8_MMA(0, 0, At, B0); PG8_MMA(0, 1, At, B1); PG8_BAR; PG8_SCHED;
            PG8_LDA(At, 1, 1); PG8_STAGE(PG8_SB(1, 0), b3, voffB); PG8_STAGE(PG8_SB(1, 1), b3 + hstep, voffB); PG8_STAGE(PG8_SA(1, 0), a3, voffA);
            PG8_WAIT_V(8); PG8_WAIT_L(0); PG8_BAR; PG8_MMA(1, 0, At, B0); PG8_MMA(1, 1, At, B1); PG8_BAR; PG8_SCHED;
            } else {
            PG8_LDB(B0, 0, 0); PG8_SCHED; PG8_LDA(At, 0, 0); PG8_STAGE(PG8_SA(1, 1), a1 + hstep, voffA);
            PG8_WAIT_L(8); PG8_BAR; PG8_WAIT_L(0); PG8_MMA(0, 0, At, B0); PG8_BAR; PG8_SCHED;
            PG8_LDB(B1, 0, 1); PG8_STAGE(PG8_SB(0, 0), b2, voffB);
            PG8_BAR; PG8_WAIT_L(0); PG8_MMA(0, 1, At, B1); PG8_BAR;
            PG8_LDA(At, 0, 1); PG8_STAGE(PG8_SA(0, 0), a2, voffA);
            PG8_BAR; PG8_WAIT_L(0); PG8_MMA(1, 0, At, B0); PG8_BAR; PG8_SCHED;
            PG8_STAGE(PG8_SB(0, 1), b2 + hstep, voffB);
            PG8_WAIT_V(6); PG8_BAR; PG8_MMA(1, 1, At, B1); PG8_BAR;
            PG8_LDB(B0, 1, 0); PG8_SCHED; PG8_LDA(At, 1, 0); PG8_STAGE(PG8_SA(0, 1), a2 + hstep, voffA);
            PG8_WAIT_L(8); PG8_BAR; PG8_WAIT_L(0); PG8_MMA(0, 0, At, B0); PG8_BAR; PG8_SCHED;
            PG8_LDB(B1, 1, 1); PG8_STAGE(PG8_SB(1, 0), b3, voffB);
            PG8_BAR; PG8_WAIT_L(0); PG8_MMA(0, 1, At, B1); PG8_BAR;
            PG8_LDA(At, 1, 1); PG8_STAGE(PG8_SA(1, 0), a3, voffA);
            PG8_BAR; PG8_WAIT_L(0); PG8_MMA(1, 0, At, B0); PG8_BAR; PG8_SCHED;
            PG8_STAGE(PG8_SB(1, 1), b3 + hstep, voffB);
            PG8_WAIT_V(6); PG8_BAR; PG8_MMA(1, 1, At, B1); PG8_BAR;
            }
        }
        if constexpr (ALIGN_EPI) { if (wr == 0) PG8_BAR; }
        if constexpr (!Epi::AFTER_DRAIN) { E(acc, cur, wr, wc, fr, fq); S.done(cur); }
        if (!has_next) break;
#pragma unroll
        for (int a = 0; a < 2; ++a)
#pragma unroll
            for (int b = 0; b < 2; ++b)
#pragma unroll
                for (int m = 0; m < 4; ++m)
#pragma unroll
                    for (int n = 0; n < 2; ++n) acc[a][b][m][n] = (f32x4){0.f, 0.f, 0.f, 0.f};
        cur = nxt; cA = nA; cB = nB; ++ui;
        if constexpr (ALIGN_EPI) { if (wr == 1) PG8_BAR; }
    }
    PG8_WAIT_V(0);
    if constexpr (!ALIGN_EPI) { if (wr == 0) PG8_BAR; }
    PG8_BAR;
    if constexpr (Epi::AFTER_DRAIN) { E.fused(acc, cur, wr, wc, fr, fq, lds, wid, lane); S.done(cur); }
#undef PG8_SA
#undef PG8_SB
#undef PG8_STAGE
#undef PG8_LDA
#undef PG8_LDB
#undef PG8_MMA
#undef PG8_WAIT_V
#undef PG8_WAIT_L
#undef PG8_BAR
#undef PG8_SCHED
}
}

#define LAS __attribute__((address_space(3)))
typedef unsigned short bf16;
typedef pg8::f32x4 f32x4;
typedef pg8::u32x4 u32x4;
typedef unsigned u32x2 __attribute__((ext_vector_type(2)));
typedef float f32x2 __attribute__((ext_vector_type(2)));
typedef short s16x8 __attribute__((ext_vector_type(8)));
typedef float f32x16 __attribute__((ext_vector_type(16)));
typedef short s16x4 __attribute__((ext_vector_type(4)));
typedef short v4i16_t __attribute__((ext_vector_type(4)));
using pg8::Unit;
using pg8::cvt_pk_bf16;

constexpr int NB = 4, S = 8192, T = NB * S, DM = 1024, NH = 8, FFN = 2816;
constexpr int IN_W = 4008, IN_WP = 4096;
constexpr float EPS = 1e-6f;
constexpr float LOG2E = 1.4426950408889634f;
constexpr float QSC_A = 0.125f * LOG2E;
constexpr float QSC_B = 0.10206207261596577f * LOG2E;
constexpr int NWAVES = 8, NTHREADS = 512;
constexpr int LDS_BYTES = 147456;

constexpr size_t MiB = 1u << 20;
constexpr size_t WS_WIN = 1 * MiB, WS_WQ = 9 * MiB, WS_WKV = 9 * MiB + 512 * 1024, WS_WA = 10 * MiB, WS_WB = 11 * MiB, WS_WOUT = 12 * MiB,
                 WS_WGU = 14 * MiB, WS_WDN = 25 * MiB;
constexpr size_t WS_KR = 31 * MiB, WS_LOGF = 35 * MiB, WS_C = 36 * MiB, WS_PSQ = 37 * MiB, WS_PSKV = 37 * MiB + 512 * 1024, WS_CS = 38 * MiB,
                 WS_PSH = 42 * MiB, WS_KMAX = 44 * MiB;
constexpr size_t WS_XN = 48 * MiB;
constexpr size_t WS_YA = 48 * MiB, WS_YB = 80 * MiB;
constexpr size_t WS_QA = 112 * MiB, WS_KA = 144 * MiB, WS_VTA = 176 * MiB;
constexpr size_t WS_MERGED = 112 * MiB;
constexpr size_t WS_CQ = 208 * MiB, WS_CKV = 224 * MiB;
constexpr size_t WS_GA = 232 * MiB, WS_GB = 296 * MiB;
constexpr size_t WS_QB = 360 * MiB, WS_KB = 408 * MiB, WS_VTB = 456 * MiB;
constexpr size_t WS_HB = 360 * MiB, WS_H2B = 424 * MiB;
constexpr size_t WS_ACT = 48 * MiB;
constexpr size_t WS_END = 488 * MiB;

__device__ __forceinline__ int pos16(int k) { return (k & 3) | ((k & 4) << 1) | ((k & 8) >> 1); }
__device__ __forceinline__ unsigned bf1(float v) { return cvt_pk_bf16(v, 0.f) & 0xffffu; }
__device__ __forceinline__ u32x4 pack8(f32x4 a, f32x4 b) { u32x4 w; w.x = cvt_pk_bf16(a[0], a[1]); w.y = cvt_pk_bf16(a[2], a[3]); w.z = cvt_pk_bf16(b[0], b[1]); w.w = cvt_pk_bf16(b[2], b[3]); return w; }
__device__ __forceinline__ u32x2 pack4(f32x4 a) { u32x2 w; w.x = cvt_pk_bf16(a[0], a[1]); w.y = cvt_pk_bf16(a[2], a[3]); return w; }
__device__ __forceinline__ float bflo(unsigned w) { return __uint_as_float(w << 16); }
__device__ __forceinline__ float bfhi(unsigned w) { return __uint_as_float(w & 0xffff0000u); }
__device__ __forceinline__ float sigmoidf_(float z) { return __builtin_amdgcn_rcpf(1.f + __expf(-z)); }
__device__ __forceinline__ float sumsq4(f32x4 v) { return (v[0] * v[0] + v[1] * v[1]) + (v[2] * v[2] + v[3] * v[3]); }
__device__ __forceinline__ float red_fq(float s) { s += __shfl_xor(s, 16); s += __shfl_xor(s, 32); return s; }

#define ACC_T const f32x4 (&acc)[2][2][4][2]
#define FOR_AI_M _Pragma("unroll") for (int ai = 0; ai < 2; ++ai) _Pragma("unroll") for (int m = 0; m < 4; ++m)

__device__ __forceinline__ unsigned vt_lane_off(int fr, int fq) { return (unsigned)((8 * fq * S + pos16(fr & ~1)) * 2 + (fr & 1) * S * 2); }
__device__ __forceinline__ void store_vt(bf16* VT, int urow, int col, unsigned loff, f32x4 v, int fr) {
    const int b = urow >> 13, s = urow & (S - 1);
    unsigned char* ub = (unsigned char*)VT + ((size_t)(b * 512 + col) * S + s) * 2;
    const bool odd = (fr & 1) != 0;
    const float mine0 = odd ? v[1] : v[0], mine1 = odd ? v[3] : v[2];
    const float give0 = odd ? v[0] : v[1], give1 = odd ? v[2] : v[3];
    const float got0 = __shfl_xor(give0, 1), got1 = __shfl_xor(give1, 1);
    const unsigned w0 = odd ? cvt_pk_bf16(got0, mine0) : cvt_pk_bf16(mine0, got0);
    const unsigned w1 = odd ? cvt_pk_bf16(got1, mine1) : cvt_pk_bf16(mine1, got1);
    *(unsigned*)(ub + loff) = w0;
    *(unsigned*)(ub + (size_t)2 * S * 2 + loff) = w1;
}

struct EpiIn {
    static constexpr bool PERM = true, AFTER_DRAIN = false, HAS_MID = false;
    unsigned char* ws; const float *b_forget, *b_gate;
    __device__ __forceinline__ void operator()(ACC_T, const Unit& u, int wr, int wc, int fr, int fq) const {
        asm volatile("" : "+v"(fr), "+v"(fq));
        bf16 *QA = (bf16*)(ws + WS_QA), *KA = (bf16*)(ws + WS_KA), *VTA = (bf16*)(ws + WS_VTA), *CQ = (bf16*)(ws + WS_CQ), *CKV = (bf16*)(ws + WS_CKV), *GA = (bf16*)(ws + WS_GA), *GB = (bf16*)(ws + WS_GB);
        float *KR = (float*)(ws + WS_KR), *LOGF = (float*)(ws + WS_LOGF), *PSQ = (float*)(ws + WS_PSQ), *PSKV = (float*)(ws + WS_PSKV);
        const int pn = u.pn, rbase = u.pm * 256 + wr * 64 + fr, cl = wc * 32 + 8 * fq;
        if (pn < 4) {
            bf16* dst = pn < 2 ? QA : KA; const float sc = pn < 2 ? QSC_A : 1.f; const int c0 = (pn & 1) * 256 + cl;
            FOR_AI_M { int row = rbase + ai * 128 + m * 16; asm volatile("" : "+v"(row) :: "memory");
#pragma unroll
                for (int bj = 0; bj < 2; ++bj) *(u32x4*)(dst + (size_t)row * 512 + c0 + bj * 128) = pack8(acc[ai][bj][m][0] * sc, acc[ai][bj][m][1] * sc); }
        } else if (pn < 6) {
            const int c0 = (pn & 1) * 256 + cl;
            FOR_AI_M { int row = rbase + ai * 128 + m * 16; asm volatile("" : "+v"(row) :: "memory");
#pragma unroll
                for (int bj = 0; bj < 2; ++bj) *(u32x4*)(VTA + (size_t)row * 512 + c0 + bj * 128) = pack8(acc[ai][bj][m][0], acc[ai][bj][m][1]); }
        } else if (pn == 6) {
            FOR_AI_M { int row = rbase + ai * 128 + m * 16; asm volatile("" : "+v"(row) :: "memory"); float s = 0.f;
#pragma unroll
                for (int bj = 0; bj < 2; ++bj) { *(u32x4*)(CQ + (size_t)row * 256 + cl + bj * 128) = pack8(acc[ai][bj][m][0], acc[ai][bj][m][1]); s += sumsq4(acc[ai][bj][m][0]) + sumsq4(acc[ai][bj][m][1]); }
                s = red_fq(s); if (fq == 0) PSQ[(size_t)row * 4 + wc] = s; }
        } else if (pn == 7) {
            FOR_AI_M { int row = rbase + ai * 128 + m * 16; asm volatile("" : "+v"(row) :: "memory");
                *(u32x4*)(CKV + (size_t)row * 128 + cl) = pack8(acc[ai][0][m][0], acc[ai][0][m][1]);
                float s = sumsq4(acc[ai][0][m][0]) + sumsq4(acc[ai][0][m][1]); s = red_fq(s); if (fq == 0) PSKV[(size_t)row * 4 + wc] = s;
                if (wc == 0) { *(f32x4*)(KR + (size_t)row * 32 + 8 * fq) = acc[ai][1][m][0]; *(f32x4*)(KR + (size_t)row * 32 + 8 * fq + 4) = acc[ai][1][m][1]; }
                else if (wc == 1 && fq == 0) {
#pragma unroll
                    for (int n = 0; n < 2; ++n) { f32x4 o;
#pragma unroll
                        for (int e = 0; e < 4; ++e) { const float z = acc[ai][1][m][n][e] + b_forget[4 * n + e]; o[e] = fminf(z, 0.f) - __logf(1.f + __expf(-fabsf(z))); }
                        *(f32x4*)(LOGF + (size_t)row * 8 + 4 * n) = o; } } }
        } else {
            bf16* dst = pn < 12 ? GA : GB; const int c0 = ((pn - 8) & 3) * 256 + cl; const float* bg = b_gate + (pn < 12 ? 0 : DM) + c0;
            f32x4 bv[2][2];
#pragma unroll
            for (int bj = 0; bj < 2; ++bj)
#pragma unroll
                for (int n = 0; n < 2; ++n) bv[bj][n] = *(const f32x4*)(bg + bj * 128 + 4 * n);
            FOR_AI_M { int row = rbase + ai * 128 + m * 16; asm volatile("" : "+v"(row) :: "memory");
#pragma unroll
                for (int bj = 0; bj < 2; ++bj) { f32x4 a = acc[ai][bj][m][0] + bv[bj][0], b = acc[ai][bj][m][1] + bv[bj][1];
#pragma unroll
                    for (int e = 0; e < 4; ++e) { a[e] = fmaxf(sigmoidf_(a[e]), 1e-30f); b[e] = fmaxf(sigmoidf_(b[e]), 1e-30f); }
                    *(u32x4*)(dst + (size_t)row * DM + c0 + bj * 128) = pack8(a, b); } }
        }
    }
};

struct EpiQup {
    static constexpr bool PERM = false, AFTER_DRAIN = false, HAS_MID = false;
    bf16 *QN, *QR; const float* PSQ; const float* CS;
    __device__ __forceinline__ void operator()(ACC_T, const Unit& u, int wr, int wc, int fr, int fq) const {
        asm volatile("" : "+v"(fr), "+v"(fq));
        const int pn = u.pn, rbase = u.pm * 256 + wr * 64 + fr;
        FOR_AI_M { int row = rbase + ai * 128 + m * 16; asm volatile("" : "+v"(row) :: "memory");
            const f32x4 ps = *(const f32x4*)(PSQ + (size_t)row * 4);
            const float r = rsqrtf(((ps[0] + ps[1]) + (ps[2] + ps[3])) * (1.f / 256.f) + EPS) * QSC_B;
            if (pn < 2) {
#pragma unroll
                for (int bj = 0; bj < 2; ++bj)
#pragma unroll
                    for (int n = 0; n < 2; ++n) { const int c = pn * 256 + bj * 128 + wc * 32 + 16 * n + 4 * fq; *(u32x2*)(QN + (size_t)row * 512 + c) = pack4(acc[ai][bj][m][n] * r); }
            } else {
                const f32x4 cs0 = *(const f32x4*)(CS + (size_t)row * 32 + 8 * fq), cs1 = *(const f32x4*)(CS + (size_t)row * 32 + 8 * fq + 4);
                const f32x4 c = {cs0[0], cs0[2], cs1[0], cs1[2]}, sn = {cs0[1], cs0[3], cs1[1], cs1[3]};
#pragma unroll
                for (int bj = 0; bj < 2; ++bj) { const int hh = 4 * bj + wc; const f32x4 x1 = acc[ai][bj][m][0], x2 = acc[ai][bj][m][1];
                    *(u32x2*)(QR + (size_t)row * 256 + hh * 32 + 4 * fq) = pack4((x1 * c - x2 * sn) * r);
                    *(u32x2*)(QR + (size_t)row * 256 + hh * 32 + 16 + 4 * fq) = pack4((x2 * c + x1 * sn) * r); }
            } }
    }
};
struct EpiKVup {
    static constexpr bool PERM = true, AFTER_DRAIN = false, HAS_MID = false;
    bf16 *KN, *VTB; const float* PSKV;
    __device__ __forceinline__ void operator()(ACC_T, const Unit& u, int wr, int wc, int fr, int fq) const {
        asm volatile("" : "+v"(fr), "+v"(fq));
        const int pn = u.pn, rbase = u.pm * 256 + wr * 64 + fr, cl = wc * 32 + 8 * fq;
        FOR_AI_M { int row = rbase + ai * 128 + m * 16; asm volatile("" : "+v"(row) :: "memory");
            const f32x4 ps = *(const f32x4*)(PSKV + (size_t)row * 4);
            const float r = rsqrtf(((ps[0] + ps[1]) + (ps[2] + ps[3])) * (1.f / 128.f) + EPS);
            if (pn < 2) {
#pragma unroll
                for (int bj = 0; bj < 2; ++bj) *(u32x4*)(KN + (size_t)row * 512 + pn * 256 + bj * 128 + cl) = pack8(acc[ai][bj][m][0] * r, acc[ai][bj][m][1] * r);
            } else {
#pragma unroll
                for (int bj = 0; bj < 2; ++bj)
#pragma unroll
                    for (int n = 0; n < 2; ++n) store_vt(VTB, u.pm * 256 + wr * 64 + ai * 128 + m * 16, (pn - 2) * 256 + wc * 32 + bj * 128 + 4 * n, vt_lane_off(fr, fq), acc[ai][bj][m][n] * r, fr);
            } }
    }
};
struct EpiMerge {
    static constexpr bool PERM = true, AFTER_DRAIN = false, HAS_MID = true;
    const bf16 *GA_, *GB_; bf16* MG;
    __device__ __forceinline__ void mid(f32x4 (&acc)[2][2][4][2], const Unit& u, int wr, int wc, int fr, int fq) const {
        asm volatile("" : "+v"(fr), "+v"(fq));
        const int rbase = u.pm * 256 + wr * 64 + fr, c0 = u.pn * 256 + wc * 32 + 8 * fq;
        FOR_AI_M { int row = rbase + ai * 128 + m * 16; asm volatile("" : "+v"(row) :: "memory");
#pragma unroll
            for (int bj = 0; bj < 2; ++bj) { const size_t off = (size_t)row * DM + c0 + bj * 128; const u32x4 a = *(const u32x4*)(GA_ + off), b = *(const u32x4*)(GB_ + off);
                const f32x4 a0 = {bflo(a.x), bfhi(a.x), bflo(a.y), bfhi(a.y)}, a1 = {bflo(a.z), bfhi(a.z), bflo(a.w), bfhi(a.w)};
                const f32x4 b0 = {bflo(b.x), bfhi(b.x), bflo(b.y), bfhi(b.y)}, b1 = {bflo(b.z), bfhi(b.z), bflo(b.w), bfhi(b.w)};
                f32x4 r0, r1;
#pragma unroll
                for (int e = 0; e < 4; ++e) { r0[e] = a0[e] * __builtin_amdgcn_rcpf(b0[e]); r1[e] = a1[e] * __builtin_amdgcn_rcpf(b1[e]); }
                acc[ai][bj][m][0] *= r0; acc[ai][bj][m][1] *= r1; } }
    }
    __device__ __forceinline__ void operator()(ACC_T, const Unit& u, int wr, int wc, int fr, int fq) const {
        asm volatile("" : "+v"(fr), "+v"(fq));
        const int rbase = u.pm * 256 + wr * 64 + fr, c0 = u.pn * 256 + wc * 32 + 8 * fq;
        FOR_AI_M { int row = rbase + ai * 128 + m * 16; asm volatile("" : "+v"(row) :: "memory");
#pragma unroll
            for (int bj = 0; bj < 2; ++bj) { const size_t off = (size_t)row * DM + c0 + bj * 128; const u32x4 g = *(const u32x4*)(GB_ + off);
                const f32x4 g0 = {bflo(g.x), bfhi(g.x), bflo(g.y), bfhi(g.y)}, g1 = {bflo(g.z), bfhi(g.z), bflo(g.w), bfhi(g.w)};
                *(u32x4*)(MG + off) = pack8(acc[ai][bj][m][0] * g0, acc[ai][bj][m][1] * g1); } }
    }
};
struct EpiOut {
    static constexpr bool PERM = true, AFTER_DRAIN = false, HAS_MID = false;
    const float* X; bf16* HB; float* PS;
    __device__ __forceinline__ void operator()(ACC_T, const Unit& u, int wr, int wc, int fr, int fq) const {
        asm volatile("" : "+v"(fr), "+v"(fq));
        const int rbase = u.pm * 256 + wr * 64 + fr, c0 = u.pn * 256 + wc * 32 + 8 * fq;
        FOR_AI_M { int row = rbase + ai * 128 + m * 16; asm volatile("" : "+v"(row) :: "memory"); float s = 0.f;
#pragma unroll
            for (int bj = 0; bj < 2; ++bj) { const size_t off = (size_t)row * DM + c0 + bj * 128;
                const f32x4 h0 = *(const f32x4*)(X + off) + acc[ai][bj][m][0], h1 = *(const f32x4*)(X + off + 4) + acc[ai][bj][m][1];
                *(u32x4*)(HB + off) = pack8(h0, h1); s += sumsq4(h0) + sumsq4(h1); }
            s = red_fq(s); if (fq == 0) PS[((size_t)u.pn * T + row) * 4 + wc] = s; }
    }
};
struct EpiDown {
    static constexpr bool PERM = true, AFTER_DRAIN = false, HAS_MID = false;
    const bf16* HB; bf16* H2; float* PS;
    __device__ __forceinline__ void operator()(ACC_T, const Unit& u, int wr, int wc, int fr, int fq) const {
        asm volatile("" : "+v"(fr), "+v"(fq));
        const int rbase = u.pm * 256 + wr * 64 + fr, c0 = u.pn * 256 + wc * 32 + 8 * fq;
        FOR_AI_M { int row = rbase + ai * 128 + m * 16; asm volatile("" : "+v"(row) :: "memory"); float s = 0.f;
#pragma unroll
            for (int bj = 0; bj < 2; ++bj) { const size_t off = (size_t)row * DM + c0 + bj * 128; const u32x4 hq = *(const u32x4*)(HB + off);
                const f32x4 b0 = {bflo(hq.x), bfhi(hq.x), bflo(hq.y), bfhi(hq.y)}, b1 = {bflo(hq.z), bfhi(hq.z), bflo(hq.w), bfhi(hq.w)};
                const f32x4 h0 = b0 + acc[ai][bj][m][0], h1 = b1 + acc[ai][bj][m][1];
                *(u32x4*)(H2 + off) = pack8(h0, h1); s += sumsq4(h0) + sumsq4(h1); }
            s = red_fq(s); if (fq == 0) PS[((size_t)u.pn * T + row) * 4 + wc] = s; }
    }
};
struct EpiGU {
    static constexpr bool PERM = true, AFTER_DRAIN = false, HAS_MID = false;
    const float* PS; bf16* ACT;
    __device__ __forceinline__ void operator()(ACC_T, const Unit& u, int wr, int wc, int fr, int fq) const {
        asm volatile("" : "+v"(fr), "+v"(fq));
        const int rbase = u.pm * 256 + wr * 64 + fr, c0 = u.pn * 128 + wc * 32 + 8 * fq;
        FOR_AI_M { int row = rbase + ai * 128 + m * 16; asm volatile("" : "+v"(row) :: "memory");
            const f32x4* pp = (const f32x4*)(PS + (size_t)row * 4); const f32x4 p0 = pp[0], p1 = pp[T], p2 = pp[2 * T], p3 = pp[3 * T];
            const f32x4 pt = (p0 + p1) + (p2 + p3);
            const float r = rsqrtf(((pt[0] + pt[1]) + (pt[2] + pt[3])) * (1.f / 1024.f) + EPS);
            f32x4 o[2];
#pragma unroll
            for (int n = 0; n < 2; ++n)
#pragma unroll
                for (int e = 0; e < 4; ++e) { const float g = acc[ai][0][m][n][e] * r, up = acc[ai][1][m][n][e] * r; o[n][e] = g * sigmoidf_(g) * up; }
            *(u32x4*)(ACT + (size_t)row * FFN + c0) = pack8(o[0], o[1]); }
    }
};

namespace att {
__device__ __forceinline__ int crow(int r, int hi) { return (r & 3) + 8 * (r >> 2) + 4 * hi; }
__device__ __forceinline__ float max3f(float a, float b, float c) { return fmaxf(fmaxf(a, b), c); }

template <int NDC, bool FOX>
__device__ __forceinline__ void attn_unit(LAS unsigned char* lds, unsigned char* ws, int bh, int qb) {
    asm volatile("" : "+s"(ws));
    const bf16* Q = (const bf16*)(ws + (FOX ? WS_QA : WS_QB)); const bf16* Q2 = (const bf16*)(ws + WS_QB) + (size_t)T * 512;
    const bf16* K = (const bf16*)(ws + (FOX ? WS_KA : WS_KB)); const bf16* VT = (const bf16*)(ws + (FOX ? WS_VTA : WS_VTB));
    const float* Cc = (const float*)(ws + WS_C); bf16* O = (bf16*)(ws + WS_YA) + (FOX ? 0 : 512);
    constexpr int DQK = NDC * 16, PITCH = 8 * DQK, KS = FOX ? 176 : DQK * 2 + 16, VS = 144, KBYTES = 64 * KS, VBYTES = FOX ? 8192 : 64 * VS, VBASE = 2 * KBYTES, KCH = NDC * 2, NKC = 64 * KCH;
    constexpr float THR = 8.f, CUT = 40.f;
    int tid_ = threadIdx.x; asm volatile("" : "+v"(tid_));
    const int tid = tid_, lane = tid & 63, r32 = lane & 31, hi = lane >> 5, wid = __builtin_amdgcn_readfirstlane(tid >> 6);
    const int b = bh >> 3, h = bh & 7, q0 = qb * 256;
    const size_t rowbase = (size_t)b * S;
    const int NT = q0 / 64 + 4, ntw = (q0 + 32 * wid) / 64 + 1;
    const int kr0 = tid / KCH, kc0 = tid % KCH, kr1 = (tid + 512) / KCH, kc1 = (tid + 512) % KCH;
    const bool has2 = (NKC > 512) && (tid + 512 < NKC);
    const int kr1s = has2 ? kr1 : 0, kc1s = has2 ? kc1 : 0;
    const unsigned ko0 = (FOX || kc0 < 8) ? (unsigned)(((int)rowbase + kr0) * 512 + h * 64 + kc0 * 8) * 2u : (unsigned)(T * 512 + ((int)rowbase + kr0) * 32 + (kc0 - 8) * 8) * 2u;
    const unsigned ko1 = (kc1s < 8) ? (unsigned)(((int)rowbase + kr1s) * 512 + h * 64 + kc1s * 8) * 2u : (unsigned)(T * 512 + ((int)rowbase + kr1s) * 32 + (kc1s - 8) * 8) * 2u;
    const unsigned kst0 = (FOX || kc0 < 8) ? 64u * 512u * 2u : 64u * 32u * 2u, kst1 = (kc1s < 8) ? 64u * 512u * 2u : 64u * 32u * 2u;
    const int vr = tid >> 3, vc = tid & 7;
    const unsigned vo = FOX ? (unsigned)(((int)rowbase + vr) * 512 + h * 64 + vc * 8) * 2u : (unsigned)((bh * 64 + vr) * S + vc * 8) * 2u;
    const unsigned vst = FOX ? 64u * 512u * 2u : 128u;
    const float* cg_ = Cc + (size_t)bh * S;
    float cref = 0.f; if (FOX) cref = cg_[q0];
    const unsigned kl0 = kr0 * KS + kc0 * 16, kl1 = kr1 * KS + kc1 * 16, vl = FOX ? VBASE + (vc >> 2) * 4096 + (vr >> 4) * 1024 + (vr & 15) * 64 + (vc & 3) * 16 : VBASE + vr * VS + vc * 16, bl = tid * KS + 128;
#define ATT_GP(base, off) ((const __attribute__((address_space(1))) u32x4*)((const __attribute__((address_space(1))) unsigned char*)(base) + (off)))
    u32x4 kA0, kA1 = {0, 0, 0, 0}, vA, kB0, kB1 = {0, 0, 0, 0}, vB; float bA = 0.f, bB = 0.f;
#define ATT_LOAD(t, K0, K1, V, B) do { K0 = *ATT_GP(K, ko0 + (unsigned)(t) * kst0); if (has2) K1 = *ATT_GP(K, ko1 + (unsigned)(t) * kst1); V = *ATT_GP(VT, vo + (unsigned)(t) * vst); \
        if (FOX && tid < 64) B = (cref - ((const __attribute__((address_space(1))) float*)cg_)[(t) * 64 + tid]) * LOG2E; } while (0)
#define ATT_STORE(t, K0, K1, V, B) do { const unsigned bufo_ = ((t) & 1) * KBYTES; *(LAS u32x4*)(lds + bufo_ + kl0) = K0; if (has2) *(LAS u32x4*)(lds + bufo_ + kl1) = K1; \
        *(LAS u32x4*)(lds + ((t) & 1) * VBYTES + vl) = V; \
        if (FOX && tid < 64) { const unsigned h0 = bf1(B); const float r1 = B - bflo(h0); const unsigned h1 = bf1(r1); const float r2 = r1 - bflo(h1); const unsigned h2 = bf1(r2); \
            *(LAS u32x4*)(lds + bufo_ + bl) = (u32x4){h0 | (h1 << 16), h2 | 0x3F800000u, 0x3F803F80u, 0u}; } } while (0)
    const unsigned koff = r32 * KS + hi * 16, kaoff = r32 * KS + 128, voff = FOX ? VBASE + ((lane >> 4) & 1) * 32 + (lane & 3) * 8 + (4 * hi + ((lane & 15) >> 2)) * 64 : VBASE + r32 * VS + hi * 16;
    const unsigned one2_ = hi == 0 ? 0x3F803F80u : 0u;
    u32x4 qaug_w = {one2_, one2_ & 0xffffu, 0u, 0u};
    const s16x8 kaug_c = {0, 0, 0, (short)0x3F80, (short)0x3F80, (short)0x3F80, 0, 0};
#define ATT_SETM(mref) do { const float nm_ = -(mref); const unsigned h0 = bf1(nm_); const float r1 = nm_ - bflo(h0); const unsigned h1 = bf1(r1); const float r2 = r1 - bflo(h1); const unsigned h2 = bf1(r2); \
        qaug_w.y = hi == 0 ? ((one2_ & 0xffffu) | (h0 << 16)) : 0u; qaug_w.z = hi == 0 ? (h1 | (h2 << 16)) : 0u; } while (0)
    s16x8 qr[NDC];
    constexpr int NOPS = 2 * (NDC + 1);
#define ATT_KF(i, kb_) ((((i) >> 1) < NDC) ? *(const LAS s16x8*)(lds + (kb_) + koff + ((((i) >> 1) < NDC) ? ((i) >> 1) : 0) * 32 + ((i) & 1) * 32 * KS) \
                                            : (FOX ? *(const LAS s16x8*)(lds + (kb_) + kaoff + ((i) & 1) * 32 * KS) : kaug_c))
#define ATT_QKOP(i, N0, N1) do { constexpr int i_ = (i), d_ = i_ >> 1, blk_ = i_ & 1; if (i_ < NOPS) { \
        const s16x8 qf_ = d_ < NDC ? qr[d_ < NDC ? d_ : 0] : __builtin_bit_cast(s16x8, qaug_w); \
        if (blk_ == 0) N0 = __builtin_amdgcn_mfma_f32_32x32x16_bf16(ATT_KF(i_ < NOPS ? i_ : 0, kq_), qf_, d_ == 0 ? (f32x16){} : N0, 0, 0, 0); \
        else N1 = __builtin_amdgcn_mfma_f32_32x32x16_bf16(ATT_KF(i_ < NOPS ? i_ : 0, kq_), qf_, d_ == 0 ? (f32x16){} : N1, 0, 0, 0); } } while (0)
#define ATT_QK(N0, N1, t) do { const unsigned kq_ = ((t) & 1) * KBYTES; \
        ATT_QKOP(0, N0, N1); ATT_QKOP(1, N0, N1); ATT_QKOP(2, N0, N1); ATT_QKOP(3, N0, N1); ATT_QKOP(4, N0, N1); ATT_QKOP(5, N0, N1); ATT_QKOP(6, N0, N1); ATT_QKOP(7, N0, N1); \
        if (FOX) { ATT_QKOP(8, N0, N1); ATT_QKOP(9, N0, N1); } \
        else { ATT_QKOP(8, N0, N1); ATT_QKOP(9, N0, N1); ATT_QKOP(10, N0, N1); ATT_QKOP(11, N0, N1); \
               if (aug_on) { ATT_QKOP(12, N0, N1); ATT_QKOP(13, N0, N1); } } } while (0)
    ATT_LOAD(NT - 1, kA0, kA1, vA, bA);
    { const size_t qrow = rowbase + q0 + wid * 32 + r32;
      const bf16* qp = Q + qrow * 512 + h * 64 + hi * 8;
#pragma unroll
      for (int d0 = 0; d0 < 4; ++d0) qr[d0] = *(const s16x8*)(qp + d0 * 16);
      if (NDC > 4) { const bf16* qp2 = Q2 + qrow * 256 + h * 32 + hi * 8;
#pragma unroll
        for (int d0 = 4; d0 < NDC; ++d0) qr[d0] = *(const s16x8*)(qp2 + (d0 - 4) * 16); } }
    ATT_STORE(NT - 1, kA0, kA1, vA, bA);
    volatile LAS unsigned* vote = (volatile LAS unsigned*)(lds + 131072 + 128);
    if (FOX && lane < 2) vote[lane * 8 + wid] = 0u;
    ATT_LOAD(NT - 2, kB0, kB1, vB, bB);
    float m_ref = 0.f; f32x16 o0 = {}, o1 = {}; f32x2 lacc = {0.f, 0.f};
    bool aug_on = FOX;
    const int qabs = q0 + wid * 32 + r32;
    float qkb = 0.f;
    if (FOX) { float ssq = 0.f;
#pragma unroll
        for (int d0 = 0; d0 < 4; ++d0) { const u32x4 w = __builtin_bit_cast(u32x4, qr[d0]);
#pragma unroll
            for (int e = 0; e < 4; ++e) { const float a = bflo(w[e]), b = bfhi(w[e]); ssq += a * a + b * b; } }
        { auto rr = __builtin_amdgcn_permlane32_swap(__float_as_uint(ssq), __float_as_uint(ssq), false, false); ssq = __uint_as_float(rr[0]) + __uint_as_float(rr[1]); }
        const float kmax2 = __uint_as_float(((const unsigned*)(ws + WS_KMAX))[bh]);
        qkb = sqrtf(ssq * kmax2) * 1.001f + 0.01f; }
#define ATT_ROWMAX(rm, P0, P1) do { rm = max3f(P0[0], P0[1], P1[0]); \
        _Pragma("unroll") for (int r = 1; r < 16; ++r) rm = max3f(rm, P0[r], P1[r]); \
        rm = fmaxf(rm, P1[0]); rm = fmaxf(rm, P1[1]); \
        { auto rr = __builtin_amdgcn_permlane32_swap(__float_as_uint(rm), __float_as_uint(rm), false, false); rm = fmaxf(__uint_as_float(rr[0]), __uint_as_float(rr[1])); } } while (0)
#define ATT_EXPC(c, P) do { constexpr int o_ = ((c) & 1) * 8; \
        _Pragma("unroll") for (int r = 0; r < 8; ++r) P[o_ + r] = __builtin_amdgcn_exp2f(P[o_ + r]); \
        lacc += (f32x2){P[o_], P[o_ + 1]} + (f32x2){P[o_ + 2], P[o_ + 3]}; lacc += (f32x2){P[o_ + 4], P[o_ + 5]} + (f32x2){P[o_ + 6], P[o_ + 7]}; \
        u32x4 w; w.x = cvt_pk_bf16(P[o_], P[o_ + 1]); w.y = cvt_pk_bf16(P[o_ + 2], P[o_ + 3]); w.z = cvt_pk_bf16(P[o_ + 4], P[o_ + 5]); w.w = cvt_pk_bf16(P[o_ + 6], P[o_ + 7]); \
        pa[c] = __builtin_bit_cast(s16x8, w); } while (0)
#define ATT_EXPCD(c, P, dl_) do { constexpr int o_ = ((c) & 1) * 8; \
        _Pragma("unroll") for (int r = 0; r < 8; ++r) P[o_ + r] = __builtin_amdgcn_exp2f(P[o_ + r] - (dl_)); \
        lacc += (f32x2){P[o_], P[o_ + 1]} + (f32x2){P[o_ + 2], P[o_ + 3]}; lacc += (f32x2){P[o_ + 4], P[o_ + 5]} + (f32x2){P[o_ + 6], P[o_ + 7]}; \
        u32x4 w; w.x = cvt_pk_bf16(P[o_], P[o_ + 1]); w.y = cvt_pk_bf16(P[o_ + 2], P[o_ + 3]); w.z = cvt_pk_bf16(P[o_ + 4], P[o_ + 5]); w.w = cvt_pk_bf16(P[o_ + 6], P[o_ + 7]); \
        pa[c] = __builtin_bit_cast(s16x8, w); __builtin_amdgcn_sched_barrier(0); } while (0)
#define ATT_SOFTD(P0, P1, dl_) do { ATT_EXPCD(0, P0, dl_); ATT_EXPCD(1, P0, dl_); ATT_EXPCD(2, P1, dl_); ATT_EXPCD(3, P1, dl_); } while (0)
#define ATT_SOFT(P0, P1) do { ATT_EXPC(0, P0); ATT_EXPC(1, P0); ATT_EXPC(2, P1); ATT_EXPC(3, P1); } while (0)
#define ATT_VTR(p_) __builtin_bit_cast(s16x4, __builtin_amdgcn_ds_read_tr16_b64_v4i16((LAS v4i16_t*)(p_)))
#define ATT_VLOAD(t) do { const unsigned vb_ = ((t) & 1) * VBYTES; \
        if (FOX) { _Pragma("unroll") for (int g = 0; g < 4; ++g) _Pragma("unroll") for (int dh = 0; dh < 2; ++dh) { \
            const s16x4 lo_ = ATT_VTR(lds + vb_ + voff + dh * 4096 + g * 1024), hi_ = ATT_VTR(lds + vb_ + voff + dh * 4096 + g * 1024 + 512); \
            vf[2 * g + dh] = (s16x8){lo_[0], lo_[1], lo_[2], lo_[3], hi_[0], hi_[1], hi_[2], hi_[3]}; } } \
        else { _Pragma("unroll") for (int g = 0; g < 4; ++g) { vf[2 * g] = *(const LAS s16x8*)(lds + vb_ + voff + g * 32); vf[2 * g + 1] = *(const LAS s16x8*)(lds + vb_ + voff + 32 * VS + g * 32); } } } while (0)
#define ATT_PV() do { __builtin_amdgcn_sched_barrier(0); \
        _Pragma("unroll") for (int g = 0; g < 4; ++g) { \
            o0 = __builtin_amdgcn_mfma_f32_32x32x16_bf16(vf[2 * g], pa[g], o0, 0, 0, 0); \
            o1 = __builtin_amdgcn_mfma_f32_32x32x16_bf16(vf[2 * g + 1], pa[g], o1, 0, 0, 0); } } while (0)
#define ATT_STEP(t, LK0, LK1, LV, LB, SK0, SK1, SV, SB_) do { \
        asm volatile("s_waitcnt lgkmcnt(0)\n\ts_barrier" ::: "memory");     \
        if (FOX) { const u32x4 va_ = *(const volatile LAS u32x4*)(vote + (((t) + 1) & 1) * 8), vb_ = *(const volatile LAS u32x4*)(vote + (((t) + 1) & 1) * 8 + 4); \
            if ((va_.x & va_.y & va_.z & va_.w & vb_.x & vb_.y & vb_.z & vb_.w) != 0u) goto att_done; }     \
        if ((t) >= 2) ATT_LOAD((t) - 2, LK0, LK1, LV, LB); \
        if ((t) < ntw) { \
            s16x8 pa[4], vf[8]; float rm; f32x16 p0, p1; \
            if (FOX && (t) < ntw - 1 && __all(qkb + (cref - cg_[(t) * 64 + 63]) * LOG2E - m_ref < -CUT)) {     \
                if (lane == 0) vote[((t) & 1) * 8 + wid] = 1u; \
            } else { \
            ATT_QK(p0, p1, t); \
            if ((t) == ntw - 1) {                             \
                if (FOX) { int qa_ = qabs; asm volatile("" : "+v"(qa_)); const int kb = (t) * 64 + 4 * hi; \
                    _Pragma("unroll") for (int r = 0; r < 16; ++r) { const int kv = kb + (r & 3) + 8 * (r >> 2); if (kv > qa_) p0[r] = -1e30f; if (kv + 32 > qa_) p1[r] = -1e30f; } } \
                ATT_ROWMAX(rm, p0, p1); \
                if (FOX || __any(fabsf(rm) > THR)) { m_ref = rm; ATT_SETM(m_ref); aug_on = true; \
                    _Pragma("unroll") for (int r = 0; r < 16; ++r) { p0[r] -= rm; p1[r] -= rm; } \
                    ATT_SOFT(p0, p1); ATT_VLOAD(t); ATT_PV(); \
                } else { ATT_SOFT(p0, p1); ATT_VLOAD(t); ATT_PV(); }     \
            } else { \
                ATT_ROWMAX(rm, p0, p1); \
                if (FOX && __all(rm < -CUT)) {               \
                } else if (__builtin_expect(__any(rm > THR), 0)) { const float dl = fmaxf(rm, 0.f); m_ref += dl; ATT_SETM(m_ref); aug_on = true; \
                    const float al = __builtin_amdgcn_exp2f(-dl); o0 *= al; o1 *= al; lacc *= al; \
                    __builtin_amdgcn_sched_barrier(0); \
                    ATT_SOFTD(p0, p1, dl); ATT_VLOAD(t); ATT_PV(); \
                } else { ATT_SOFT(p0, p1); ATT_VLOAD(t); ATT_PV(); } \
            } \
            } \
        } \
        if ((t) >= 1) ATT_STORE((t) - 1, SK0, SK1, SV, SB_); } while (0)
    for (int t = NT - 1; t >= 1; t -= 2) {
        ATT_STEP(t, kA0, kA1, vA, bA, kB0, kB1, vB, bB);
        ATT_STEP(t - 1, kB0, kB1, vB, bB, kA0, kA1, vA, bA);
    }
att_done:
    asm volatile("s_waitcnt lgkmcnt(0)\n\ts_barrier" ::: "memory");
#undef ATT_ROWMAX
#undef ATT_QKOP
#undef ATT_EXPC
#undef ATT_SOFT
#undef ATT_SOFTD
#undef ATT_EXPCD
#undef ATT_VLOAD
#undef ATT_VTR
#undef ATT_PV
#undef ATT_KF
#undef ATT_STEP
#undef ATT_LOAD
#undef ATT_GP
#undef ATT_STORE
#undef ATT_QK
#undef ATT_SETM
    float l_ = lacc[0] + lacc[1];
    { auto rr = __builtin_amdgcn_permlane32_swap(__float_as_uint(l_), __float_as_uint(l_), false, false); l_ = __uint_as_float(rr[0]) + __uint_as_float(rr[1]); }
    const float inv = 1.f / l_;
    int lane_o = lane; asm volatile("" : "+v"(lane_o));
    bf16* op = O + (rowbase + q0 + wid * 32 + (lane_o & 31)) * 1024 + h * 64 + 4 * (lane_o >> 5);
#pragma unroll
    for (int i = 0; i < 4; ++i) {
        const f32x4 a = {o0[4 * i] * inv, o0[4 * i + 1] * inv, o0[4 * i + 2] * inv, o0[4 * i + 3] * inv};
        const f32x4 c = {o1[4 * i] * inv, o1[4 * i + 1] * inv, o1[4 * i + 2] * inv, o1[4 * i + 3] * inv};
        *(u32x2*)(op + 8 * i) = pack4(a); *(u32x2*)(op + 32 + 8 * i) = pack4(c);
    }
}
}

__device__ __forceinline__ float wave_sum(float v) {
#pragma unroll
    for (int o = 1; o < 64; o <<= 1) v += __shfl_xor(v, o);
    return v;
}
enum { MAP_ID = 0, MAP_IN, MAP_QUP, MAP_KVUP, MAP_GATE, MAP_UP };
__device__ __forceinline__ int map_row(int kind, int n) {
    switch (kind) {
        case MAP_IN:
            if (n < 1536) return n;
            if (n < 1544) return 1952 + (n - 1536);
            if (n < 1800) return 1536 + (n - 1544);
            if (n < 1928) return 1792 + (n - 1800);
            if (n < 1960) return 1920 + (n - 1928);
            return 2048 + (n - 1960);
        case MAP_QUP: { const int hh = n / 96, j = n % 96; return j < 64 ? hh * 64 + j : 512 + hh * 32 + (j - 64); }
        case MAP_KVUP: { const int hh = n >> 7, j = n & 127; return j < 64 ? hh * 64 + j : 512 + hh * 64 + (j - 64); }
        case MAP_GATE: return 256 * (n >> 7) + (n & 127);
        case MAP_UP: return 256 * (n >> 7) + 128 + (n & 127);
        default: return n;
    }
}
__device__ __forceinline__ void transpose_item(const float* W, int K, int N, bf16* WT, int kind, const float* gain, LAS float* scr, int item, int lane, int ldk = 0, int koff = 0) {
    if (ldk == 0) ldk = K;
    const int nblk = (N + 31) / 32, kb = item / nblk, nb = item % nblk, k0 = 64 * kb, n0 = 32 * nb;
    const int nl = n0 + (lane & 31);
#pragma unroll
    for (int i = 0; i < 32; ++i) { const int kk = 2 * i + (lane >> 5); float v = nl < N ? W[(size_t)(k0 + kk) * N + nl] : 0.f; if (gain) v *= gain[k0 + kk]; scr[kk * 33 + (lane & 31)] = v; }
    asm volatile("s_waitcnt lgkmcnt(0)" ::: "memory");
    const int c = lane & 7;
#pragma unroll
    for (int j = 0; j < 4; ++j) { const int n = (lane >> 3) + 8 * j; const LAS float* s = scr + (8 * c) * 33 + n;
        if (n0 + n < N) { u32x4 o; o.x = cvt_pk_bf16(s[0 * 33], s[1 * 33]); o.y = cvt_pk_bf16(s[2 * 33], s[3 * 33]); o.z = cvt_pk_bf16(s[4 * 33], s[5 * 33]); o.w = cvt_pk_bf16(s[6 * 33], s[7 * 33]);
            *(u32x4*)(WT + (size_t)map_row(kind, n0 + n) * ldk + koff + k0 + 8 * c) = o; } }
    asm volatile("s_waitcnt lgkmcnt(0)" ::: "memory");
}
__device__ __forceinline__ void cossin(double ang, float& c, float& s) {
    const double kd = __builtin_rint(ang * 0.6366197723675814);
    double r = __builtin_fma(-kd, 1.5707963267948966, ang); r = __builtin_fma(-kd, 6.123233995736766e-17, r);
    const int q = (int)kd & 3; const float x = (float)r, x2 = x * x;
    const float sn = x * (1.f + x2 * (-1.f / 6.f + x2 * (1.f / 120.f + x2 * (-1.f / 5040.f + x2 * (1.f / 362880.f)))));
    const float cs = 1.f + x2 * (-0.5f + x2 * (1.f / 24.f + x2 * (-1.f / 720.f + x2 * (1.f / 40320.f + x2 * (-1.f / 3628800.f)))));
    c = (q == 0) ? cs : (q == 1) ? -sn : (q == 2) ? -cs : sn;
    s = (q == 0) ? sn : (q == 1) ? cs : (q == 2) ? -sn : -cs;
}

#define XB_TMO      128
#define XB_XCNT(j)  (256  + 64 * (j))
#define XB_XSUB(j)  (1280 + 64 * (j))
#define XB_XGEN(j)  (2304 + 64 * (j))
#define XB_TOP      3328
#define XB_TOPGEN   3392
#define XCD_BAR_WORDS 3456
#define XB_SPIN_CAP (1u << 18)

__device__ __forceinline__ unsigned xb_ld(unsigned* p)              { return __hip_atomic_load(p, __ATOMIC_RELAXED, __HIP_MEMORY_SCOPE_AGENT); }
__device__ __forceinline__ unsigned xb_add(unsigned* p, unsigned v) { return __hip_atomic_fetch_add(p, v, __ATOMIC_RELAXED, __HIP_MEMORY_SCOPE_AGENT); }
__device__ __forceinline__ unsigned xb_xcc_id() { return (unsigned)__builtin_amdgcn_s_getreg((3 << 11) | 20) & 0xFu; }
#define XB_SPIN(cond, bar) do { unsigned _sp = 0; while (cond) { __builtin_amdgcn_s_sleep(1); \
    if ((++_sp & 255u) == 0u) { if (xb_ld(&(bar)[XB_TMO])) break; if (_sp > XB_SPIN_CAP) { atomicAdd(&(bar)[XB_TMO], 1u); break; } } } } while (0)

struct XcdBarrier {
    unsigned* bar; unsigned x;
    volatile LAS unsigned* st;
};

__device__ __forceinline__ XcdBarrier xcd_barrier_post(unsigned* bar, volatile LAS unsigned* st) {
    XcdBarrier b; b.bar = bar; b.x = xb_xcc_id(); b.st = st;
    if (threadIdx.x == 0) (void)xb_add(&bar[XB_XCNT(b.x)], 1u);
    return b;
}
__device__ __forceinline__ void xcd_barrier_complete(unsigned* bar, unsigned x, unsigned& nloc, unsigned& nx) {
    const unsigned G = gridDim.x * gridDim.y * gridDim.z;
    unsigned sum, cnt, mine, sp = 0u;
    for (;;) {
        sum = 0u; cnt = 0u; mine = 0u;
#pragma unroll
        for (unsigned j = 0; j < 16; ++j) { const unsigned c = xb_ld(&bar[XB_XCNT(j)]); sum += c; cnt += (c > 0u) ? 1u : 0u; mine = (j == x) ? c : mine; }
        if (sum == G) break;
        __builtin_amdgcn_s_sleep(1);
        if ((++sp & 255u) == 0u) { if (xb_ld(&bar[XB_TMO])) break; if (sp > XB_SPIN_CAP) { atomicAdd(&bar[XB_TMO], 1u); break; } }
    }
    nloc = mine > 0u ? mine : 1u; nx = cnt > 0u ? cnt : 1u;
}

__device__ __forceinline__ void xcd_barrier(const XcdBarrier& b) {
    asm volatile("s_waitcnt vmcnt(0)" ::: "memory");
    __syncthreads();
    if (threadIdx.x == 0) {
        unsigned* bar = b.bar;
        __builtin_amdgcn_s_waitcnt(0);
        unsigned nloc = b.st[0], nx = b.st[1];
        if (nloc == 0u) { xcd_barrier_complete(bar, b.x, nloc, nx); b.st[0] = nloc; b.st[1] = nx; }
        const unsigned old = xb_add(&bar[XB_XSUB(b.x)], 1u);
        const unsigned gen = old / nloc;
        if (old + 1u == (gen + 1u) * nloc) {
            __builtin_amdgcn_fence(__ATOMIC_RELEASE, "agent");
            asm volatile("s_waitcnt vmcnt(0)" ::: "memory");
            const unsigned og = xb_add(&bar[XB_TOP], 1u);
            const unsigned tg = og / nx;
            if (og + 1u == (tg + 1u) * nx) xb_add(&bar[XB_TOPGEN], 1u);
            else XB_SPIN(xb_ld(&bar[XB_TOPGEN]) == tg, bar);
            __builtin_amdgcn_fence(__ATOMIC_ACQUIRE, "agent");
            xb_add(&bar[XB_XGEN(b.x)], 1u);
            asm volatile("s_waitcnt vmcnt(0)" ::: "memory");
        } else {
            XB_SPIN(xb_ld(&bar[XB_XGEN(b.x)]) == gen, bar);
            __builtin_amdgcn_fence(__ATOMIC_ACQUIRE, "agent");
            asm volatile("s_waitcnt vmcnt(0)" ::: "memory");
        }
    }
    __syncthreads();
}

struct Args { const float* in[18]; float* out; unsigned char* ws; int ph_lo, ph_hi; };
enum { I_X = 0, I_POS, I_GMIX, I_WIN, I_BF, I_GQ, I_WQUP, I_GKV, I_WKVUP, I_WA, I_WB, I_BG, I_WOUT, I_GFFN, I_WG, I_WU, I_WD, I_GFIN };
constexpr int N_PHASES = 9;

template <class Epi> __device__ __forceinline__ void run_gemm(LAS unsigned char* lds, const bf16* A, const bf16* Bt, int M, int N, int K, int G, const Epi& E) {
    pg8::Gemm g{A, Bt, M, N, K}; pg8::StaticOrder So; So.init(M, N, G, (int)blockIdx.x);
    pg8::gemm_phase<Epi, pg8::StaticOrder, true, true>(lds, g, So, E);
}


#define P_(T_, off) ((T_*)(args.ws + (off)))
#define Win_t P_(bf16, WS_WIN)
#define Wq_t P_(bf16, WS_WQ)
#define Wkv_t P_(bf16, WS_WKV)
#define Wa_t P_(bf16, WS_WA)
#define Wb_t P_(bf16, WS_WB)
#define Wout_t P_(bf16, WS_WOUT)
#define Wgu_t P_(bf16, WS_WGU)
#define Wdn_t P_(bf16, WS_WDN)
#define KR P_(float, WS_KR)
#define LOGF P_(float, WS_LOGF)
#define CC P_(float, WS_C)
#define PSQ P_(float, WS_PSQ)
#define PSKV P_(float, WS_PSKV)
#define CS P_(float, WS_CS)
#define PSH P_(float, WS_PSH)
#define XN P_(bf16, WS_XN)
#define YA P_(bf16, WS_YA)
#define YB P_(bf16, WS_YB)
#define QA P_(bf16, WS_QA)
#define KA P_(bf16, WS_KA)
#define VTA P_(bf16, WS_VTA)
#define MG P_(bf16, WS_MERGED)
#define CQ P_(bf16, WS_CQ)
#define CKV P_(bf16, WS_CKV)
#define GA P_(bf16, WS_GA)
#define GB P_(bf16, WS_GB)
#define QB P_(bf16, WS_QB)
#define KB P_(bf16, WS_KB)
#define VTB P_(bf16, WS_VTB)
#define HB P_(bf16, WS_HB)
#define H2B P_(bf16, WS_H2B)
#define ACT P_(bf16, WS_ACT)
__global__ void __launch_bounds__(NTHREADS, 2) mega_fwd(Args args) {
    __builtin_assume(__builtin_amdgcn_workitem_id_y() == 0); __builtin_assume(__builtin_amdgcn_workitem_id_z() == 0);
    extern __shared__ __attribute__((aligned(16))) unsigned char lds_raw[];
    LAS unsigned char* lds = (LAS unsigned char*)lds_raw;
    cg::grid_group grid = cg::this_grid();
    const int wave = __builtin_amdgcn_readfirstlane((int)threadIdx.x >> 6);
    const int G = gridDim.x, bx = blockIdx.x, vcu = (G % 8 == 0) ? (bx % 8) * (G / 8) + bx / 8 : bx;
#define TID_INIT int tid = threadIdx.x; asm volatile("" : "+v"(tid)); const int lane = tid & 63, gt = bx * NTHREADS + tid; (void)lane; (void)gt
    const int lo = args.ph_lo, hi_ = args.ph_hi;
    volatile LAS unsigned* bar_st = (volatile LAS unsigned*)(lds + 131072 + 64);
    if (threadIdx.x < 2) bar_st[threadIdx.x] = 0u;
    __syncthreads();
    XcdBarrier xbar = xcd_barrier_post((unsigned*)args.ws, bar_st);
#ifdef ONLY_PHASE
#define IN(k) ((k) == ONLY_PHASE)
#else
#define IN(k) (lo <= (k) && (k) < hi_)
#endif
    if (lo < 0) grid.sync();
#define SEAM(k) do { if (IN(k) && IN((k) + 1)) xcd_barrier(xbar); } while (0)
    const int gw = vcu * NWAVES + wave, NGW = G * NWAVES;
    const int NGT = G * NTHREADS;

    if (IN(0)) { TID_INIT;
        LAS float* scr = (LAS float*)(lds + wave * 16384);
        constexpr int I_IN = 16 * 126, I_Q = 4 * 24, I_KV = 2 * 32, I_AB = 8 * 32, I_O = 16 * 32, I_GU = 16 * 88, I_D = 44 * 32;
        constexpr int NIT = I_IN + I_Q + I_KV + 2 * I_AB + I_O + 2 * I_GU + I_D;
        for (int it = gw; it < NIT; it += NGW) {
            int r = it;
            if (r < I_IN) { transpose_item(args.in[I_WIN], DM, IN_W, Win_t, MAP_IN, nullptr, scr, r, lane); continue; } r -= I_IN;
            if (r < I_Q) { transpose_item(args.in[I_WQUP], 256, 768, Wq_t, MAP_QUP, args.in[I_GQ], scr, r, lane); continue; } r -= I_Q;
            if (r < I_KV) { transpose_item(args.in[I_WKVUP], 128, 1024, Wkv_t, MAP_KVUP, args.in[I_GKV], scr, r, lane); continue; } r -= I_KV;
            if (r < I_AB) { transpose_item(args.in[I_WA], 512, DM, Wa_t, MAP_ID, nullptr, scr, r, lane, 1024, 0); continue; } r -= I_AB;
            if (r < I_AB) { transpose_item(args.in[I_WB], 512, DM, Wa_t, MAP_ID, nullptr, scr, r, lane, 1024, 512); continue; } r -= I_AB;
            if (r < I_O) { transpose_item(args.in[I_WOUT], DM, DM, Wout_t, MAP_ID, nullptr, scr, r, lane); continue; } r -= I_O;
            if (r < I_GU) { transpose_item(args.in[I_WG], DM, FFN, Wgu_t, MAP_GATE, args.in[I_GFFN], scr, r, lane); continue; } r -= I_GU;
            if (r < I_GU) { transpose_item(args.in[I_WU], DM, FFN, Wgu_t, MAP_UP, args.in[I_GFFN], scr, r, lane); continue; } r -= I_GU;
            transpose_item(args.in[I_WD], FFN, DM, Wdn_t, MAP_ID, nullptr, scr, r, lane);
        }
        if (gt < 32) ((unsigned*)(args.ws + WS_KMAX))[gt] = 0u;
        for (int i = gt; i < 88 * DM / 8; i += NGT) *(u32x4*)(Win_t + (size_t)1960 * DM + (size_t)i * 8) = (u32x4){0u, 0u, 0u, 0u};
        { const float* gm = args.in[I_GMIX]; f32x4 gv[4];
#pragma unroll
          for (int j = 0; j < 4; ++j) gv[j] = *(const f32x4*)(gm + 4 * lane + 256 * j);
          for (int mrow = gw; mrow < T; mrow += 4 * NGW) {
            f32x4 v[4][4]; float ss[4];
#pragma unroll
            for (int q = 0; q < 4; ++q) { const f32x4* xr = (const f32x4*)(args.in[I_X] + (size_t)(mrow + q * NGW) * DM) + lane;
#pragma unroll
              for (int j = 0; j < 4; ++j) v[q][j] = xr[64 * j]; }
#pragma unroll
            for (int q = 0; q < 4; ++q) { float s = 0.f;
#pragma unroll
              for (int j = 0; j < 4; ++j) s += sumsq4(v[q][j]);
              ss[q] = s; }
#pragma unroll
            for (int o = 1; o < 64; o <<= 1) {
#pragma unroll
              for (int q = 0; q < 4; ++q) ss[q] += __shfl_xor(ss[q], o); }
#pragma unroll
            for (int q = 0; q < 4; ++q) { const float rstd = rsqrtf(ss[q] * (1.f / DM) + EPS);
#pragma unroll
              for (int j = 0; j < 4; ++j) *(u32x2*)(XN + (size_t)(mrow + q * NGW) * DM + 4 * lane + 256 * j) = pack4(v[q][j] * rstd * gv[j]); }
          } }
        { const int* pos = (const int*)args.in[I_POS];
          constexpr double IF[16] = {1.0, 0.5623413251903491, 0.31622776601683794, 0.1778279410038923, 0.1, 0.05623413251903491, 0.03162277660168379, 0.01778279410038923,
                                     0.01, 0.005623413251903491, 0.0031622776601683794, 0.0017782794100389228, 0.001, 0.0005623413251903491, 0.00031622776601683794, 0.00017782794100389227};
          for (int t = gt; t < T; t += NGT) { const double p = (double)pos[t];
#pragma unroll
            for (int j = 0; j < 16; j += 2) { float c0, s0, c1, s1; cossin(p * IF[j], c0, s0); cossin(p * IF[j + 1], c1, s1); *(f32x4*)(CS + (size_t)t * 32 + 2 * j) = (f32x4){c0, s0, c1, s1}; } } }
    }
    SEAM(0);
    if (IN(1)) {
        EpiIn E{args.ws, args.in[I_BF], args.in[I_BG]};
#if defined(DUP_PHASE) && DUP_PHASE == 1
        run_gemm(lds, XN, Win_t, T, IN_WP, DM, G, E);
#endif
        run_gemm(lds, XN, Win_t, T, IN_WP, DM, G, E);
    }
    SEAM(1);
    if (IN(2)) { TID_INIT;
        LAS double* sw = (LAS double*)lds;
        for (int j = vcu; j < NB * NH; j += G) {
            const int b = j >> 3, h = j & 7; const float* src = LOGF + ((size_t)b * S + tid * 16) * 8 + h;
            double v[16]; double run = 0.0;
#pragma unroll
            for (int i = 0; i < 16; ++i) { run += (double)src[i * 8]; v[i] = run; }
            double xs = run;
#pragma unroll
            for (int o = 1; o < 64; o <<= 1) { const double y = __shfl_up(xs, o); if (lane >= o) xs += y; }
            if (lane == 63) sw[wave] = xs;
            __syncthreads();
            double base = 0.0;
            for (int w = 0; w < wave; ++w) base += sw[w];
            const double excl = base + xs - run;
            float* dst = CC + (size_t)j * S + tid * 16;
#pragma unroll
            for (int i = 0; i < 16; i += 4) *(f32x4*)(dst + i) = (f32x4){(float)(excl + v[i]), (float)(excl + v[i + 1]), (float)(excl + v[i + 2]), (float)(excl + v[i + 3])};
            __syncthreads();
        }
        for (int idx = gt; idx < T * 8; idx += NGT) {
            const int hh = idx >> 15, t = idx & (T - 1); const u32x4* kp = (const u32x4*)(KA + (size_t)t * 512 + hh * 64); float ssq = 0.f;
#pragma unroll
            for (int c8 = 0; c8 < 8; ++c8) { const u32x4 w = kp[c8];
#pragma unroll
                for (int e = 0; e < 4; ++e) { const float a = bflo(w[e]), b = bfhi(w[e]); ssq += a * a + b * b; } }
#pragma unroll
            for (int o = 1; o < 64; o <<= 1) ssq = fmaxf(ssq, __shfl_xor(ssq, o));
            if (lane == 0) atomicMax((unsigned*)(args.ws + WS_KMAX) + ((t >> 13) * 8 + hh), __float_as_uint(ssq));
        }
        { bf16* KR2 = KB + (size_t)T * 512;
          for (int idx = gt; idx < T * 4; idx += NGT) {
            const int t = idx >> 2, g4 = idx & 3; const f32x4* kr = (const f32x4*)(KR + (size_t)t * 32); const f32x4* cs = (const f32x4*)(CS + (size_t)t * 32);
            const f32x4 x1 = kr[g4], x2 = kr[4 + g4], ca = cs[2 * g4], cb = cs[2 * g4 + 1];
            const f32x4 c = {ca[0], ca[2], cb[0], cb[2]}, sn = {ca[1], ca[3], cb[1], cb[3]};
            *(u32x2*)(KR2 + (size_t)t * 32 + 4 * g4) = pack4(x1 * c - x2 * sn); *(u32x2*)(KR2 + (size_t)t * 32 + 16 + 4 * g4) = pack4(x2 * c + x1 * sn);
          } }
        __syncthreads();
#if !defined(P2_PART) || P2_PART == 1
        { EpiQup E{QB, QB + (size_t)T * 512, PSQ, CS}; run_gemm(lds, CQ, Wq_t, T, 768, 256, G, E); }
#endif
#if !defined(P2_PART) || P2_PART == 2
        { EpiKVup E{KB, VTB, PSKV}; run_gemm(lds, CKV, Wkv_t, T, 1024, 128, G, E); }
#endif
    }
    SEAM(2);
    if (IN(3)) {
#ifdef DUP_P3
      for (int rep_ = 0; rep_ < 2; ++rep_) {
#endif
#define ATT_UNITS(CALL) do { \
        if (G == 256) { const int xcd_ = vcu >> 5, c_ = vcu & 31; \
            for (int r_ = 0; r_ < 4; ++r_) { const int bh = xcd_ * 4 + r_, c2_ = (c_ + 16) & 31; const int qb = r_ == 0 ? c_ : r_ == 1 ? 31 - c_ : r_ == 2 ? c2_ : 31 - c2_; CALL; } } \
        else { for (int i = vcu; i < 1024; i += G) { const int bh = (i & 255) >> 3, s_ = i & 7, rd = i >> 8; const int qb = rd == 0 ? s_ : rd == 1 ? 15 - s_ : rd == 2 ? 16 + s_ : 31 - s_; CALL; } } } while (0)
        ATT_UNITS((att::attn_unit<4, true>(lds, args.ws, bh, qb)));
        __syncthreads();
        ATT_UNITS((att::attn_unit<6, false>(lds, args.ws, bh, qb)));
#undef ATT_UNITS
        __syncthreads();
#ifdef DUP_P3
      }
#endif
    }
    SEAM(3);
    if (IN(4)) {
        { EpiMerge E{GA, GB, MG}; run_gemm(lds, YA, Wa_t, T, DM, 1024, G, E); }
    }
    SEAM(4);
    if (IN(5)) { EpiOut E{args.in[I_X], HB, PSH}; run_gemm(lds, MG, Wout_t, T, DM, DM, G, E); }
    SEAM(5);
    if (IN(6)) { EpiGU E{PSH, ACT};
#if defined(DUP_PHASE) && DUP_PHASE == 6
        run_gemm(lds, HB, Wgu_t, T, 2 * FFN, DM, G, E);
#endif
        run_gemm(lds, HB, Wgu_t, T, 2 * FFN, DM, G, E); }
    SEAM(6);
    if (IN(7)) { EpiDown E{HB, H2B, PSH}; run_gemm(lds, ACT, Wdn_t, T, DM, FFN, G, E); }
    SEAM(7);
    if (IN(8)) { TID_INIT;
        const float* gm = args.in[I_GFIN]; f32x4 gv[4];
#pragma unroll
        for (int j = 0; j < 4; ++j) gv[j] = *(const f32x4*)(gm + 4 * lane + 256 * j);
        for (int mrow = gw; mrow < T; mrow += 4 * NGW) {
            u32x2 v[4][4]; float ss[4];
#pragma unroll
            for (int q = 0; q < 4; ++q) { const int row = mrow + q * NGW; const u32x2* hr = (const u32x2*)(H2B + (size_t)row * DM) + lane;
#pragma unroll
              for (int j = 0; j < 4; ++j) v[q][j] = hr[64 * j];
              const f32x4* pp = (const f32x4*)(PSH + (size_t)row * 4); const f32x4 pt = (pp[0] + pp[T]) + (pp[2 * T] + pp[3 * T]);
              ss[q] = (pt[0] + pt[1]) + (pt[2] + pt[3]); }
#pragma unroll
            for (int q = 0; q < 4; ++q) { const float rstd = rsqrtf(ss[q] * (1.f / DM) + EPS); f32x4* xw = (f32x4*)(args.out + (size_t)(mrow + q * NGW) * DM) + lane;
#pragma unroll
              for (int j = 0; j < 4; ++j) { const f32x4 hv = {bflo(v[q][j].x), bfhi(v[q][j].x), bflo(v[q][j].y), bfhi(v[q][j].y)}; xw[64 * j] = hv * rstd * gv[j]; } }
        }
    }
#undef IN
#undef SEAM
}

#ifdef DBG_STOP
#ifndef DBG_N
#define DBG_N (T * DM)
#endif
__global__ void dbg_dump(const unsigned short* src, float* dst, int n) {
    for (int i = blockIdx.x * blockDim.x + threadIdx.x; i < n; i += gridDim.x * blockDim.x) dst[i] = i < DBG_N ? __uint_as_float((unsigned)src[i] << 16) : 0.f;
}
#endif
#ifndef MK_COOP
#define MK_COOP 1
#endif
extern "C" void kernel_launch(void* const* d_in, const int* in_sizes, int n_in, void* d_out, int out_size, void* d_ws, size_t ws_size, hipStream_t stream) {
    static int grid = 0;
    if (grid == 0) {
        if (n_in != 18 || in_sizes[0] != T * DM || out_size != T * DM || ws_size < WS_END) { fprintf(stderr, "kernel_launch: unexpected shapes (n_in %d, in0 %d, out %d, ws %zu)\n", n_in, n_in > 0 ? in_sizes[0] : -1, out_size, ws_size); grid = -1; return; }
        int dev = 0, cus = 0, per_cu = 0;
        if (hipGetDevice(&dev) != hipSuccess || hipDeviceGetAttribute(&cus, hipDeviceAttributeMultiprocessorCount, dev) != hipSuccess) { grid = -1; return; }
        if (hipFuncSetAttribute((const void*)mega_fwd, hipFuncAttributeMaxDynamicSharedMemorySize, LDS_BYTES) != hipSuccess) { fprintf(stderr, "kernel_launch: hipFuncSetAttribute failed\n"); grid = -1; return; }
        if (hipOccupancyMaxActiveBlocksPerMultiprocessor(&per_cu, (const void*)mega_fwd, NTHREADS, LDS_BYTES) != hipSuccess || per_cu < 1) { fprintf(stderr, "kernel_launch: occupancy query says %d\n", per_cu); per_cu = 1; }
        (void)hipGetLastError();
        grid = cus * 1;
    }
    if (grid < 0) return;
    Args a{};
    for (int i = 0; i < 18; ++i) a.in[i] = (const float*)d_in[i];
    a.out = (float*)d_out; a.ws = (unsigned char*)d_ws;
#if MK_COOP
    a.ph_lo = 0; a.ph_hi = N_PHASES;
    if (hipMemsetAsync(d_ws, 0, 16384, stream) != hipSuccess) { fprintf(stderr, "kernel_launch: memset of the barrier words failed\n"); return; }
    void* kargs[] = {&a};
    hipError_t e = hipLaunchCooperativeKernel((const void*)mega_fwd, dim3(grid), dim3(NTHREADS), kargs, LDS_BYTES, stream);
    if (e != hipSuccess) fprintf(stderr, "cooperative launch failed: %s (grid %d)\n", hipGetErrorString(e), grid);
#else
#ifdef DBG_STOP
    for (int p = 0; p <= DBG_STOP; ++p) { a.ph_lo = p; a.ph_hi = p + 1; hipLaunchKernelGGL(mega_fwd, dim3(grid), dim3(NTHREADS), LDS_BYTES, stream, a); }
#ifndef DBG_NO_DUMP
    hipLaunchKernelGGL(dbg_dump, dim3(2048), dim3(256), 0, stream, (const unsigned short*)((unsigned char*)d_ws + (size_t)DBG_OFF * MiB), (float*)d_out, T * DM);
#endif
#else
    for (int p = 0; p < N_PHASES; ++p) { a.ph_lo = p; a.ph_hi = p + 1; hipLaunchKernelGGL(mega_fwd, dim3(grid), dim3(NTHREADS), LDS_BYTES, stream, a); }
#endif
#endif
}
```

```cpp
#include <hip/hip_runtime.h>
#include <hip/hip_cooperative_groups.h>
#include <cstdio>
#include <cstdint>
namespace cg = cooperative_groups;
namespace pg8 {
#define PG8_LAS __attribute__((address_space(3)))
typedef unsigned short bf16_t;
typedef short bf16x8 __attribute__((ext_vector_type(8)));
typedef float f32x4 __attribute__((ext_vector_type(4)));
typedef unsigned u32x4 __attribute__((ext_vector_type(4)));
constexpr int BM = 256, BK = 64, HALF = 128, HTB = HALF * BK * 2  , STAGE_BYTES = 8 * HTB, NXCD = 8, WGM = 8;

__host__ __device__ __forceinline__ int lds_byte(int r, int c) { const int st = (r >> 4) * 2 + (c >> 5), rr = r & 15, cc = c & 31, ob = rr * 64 + cc * 2; return st * 1024 + (ob ^ (((ob >> 9) & 1) << 5)); }
__host__ __device__ __forceinline__ void stage_rc(int b, int& R, int& C) { const int st = b / 1024, sb = b % 1024, swz = sb ^ (((sb >> 9) & 1) << 5); R = (st >> 1) * 16 + swz / 64; C = (st & 1) * 32 + (swz % 64) / 2; }
__host__ __device__ __forceinline__ int perm32(int rho) { const int n = rho >> 4, i = rho & 15; return 8 * (i >> 2) + 4 * n + (i & 3); }

struct Unit { int pm, pn; };
struct Gemm { const bf16_t* A; const bf16_t* Bt; int M, N, K; };

struct StaticOrder {
    int nM, nN, nwg, G, c;
    __host__ __device__ void init(int M, int N, int G_, int c_) { nM = M / BM; nN = N / BM; nwg = nM * nN; G = G_; c = c_; }
    __host__ __device__ bool next(int i, Unit& u) const {
        const long L = (long)i * G + c; if (L >= nwg) return false;
        int wgid = (int)L; { const int q = nwg / NXCD, r = nwg % NXCD, xcd = wgid % NXCD, off = wgid / NXCD; wgid = (xcd < r ? xcd * (q + 1) : r * (q + 1) + (xcd - r) * q) + off; }
        const int nig = WGM * nN, gid = wgid / nig, fm = gid * WGM, gsz = (nM - fm) < WGM ? (nM - fm) : WGM;
        u.pm = fm + ((wgid % nig) % gsz); u.pn = (wgid % nig) / gsz; return true;
    }
    __device__ __forceinline__ void a_ready(const Unit&) const {}
    __device__ __forceinline__ void done(const Unit&) const {}
};

typedef float f32x2c __attribute__((ext_vector_type(2))); typedef __bf16 bf16x2c __attribute__((ext_vector_type(2)));
__device__ __forceinline__ unsigned cvt_pk_bf16(float lo, float hi) { const f32x2c v = {lo, hi}; const bf16x2c b = __builtin_convertvector(v, bf16x2c); return __builtin_bit_cast(unsigned, b); }
template <class Epi, class Sched, bool ALIGN_EPI = false, bool SP2 = false>
__device__ __forceinline__ void gemm_phase(PG8_LAS unsigned char* lds, const Gemm g, const Sched& S, const Epi& E) {
    int tid_ = threadIdx.x; asm volatile("" : "+v"(tid_));
    const int tid = tid_, wid = __builtin_amdgcn_readfirstlane(tid >> 6), lane = tid & 63, wr = wid >> 2, wc = wid & 3, fr = lane & 15, fq = lane >> 4;
    const int K = g.K, nt = K / BK;
    unsigned voffA[2], voffB[2];
#pragma unroll
    for (int i = 0; i < 2; ++i) { int R, C; stage_rc(tid * 16 + i * 8192, R, C); const int Rb = Epi::PERM ? ((R & ~31) + perm32(R & 31)) : R;
        voffA[i] = (unsigned)(R * K + C) * 2u; voffB[i] = (unsigned)(Rb * K + C) * 2u; }
    const size_t kstep = (size_t)(BK * 2);
    const size_t hstep = (size_t)HALF * K * 2;
    const size_t tstep = 2 * hstep;
    const unsigned ldsw = (unsigned)wid * 1024u;
    const int aoff = lds_byte(wr * 64 + fr, fq * 8), boff = lds_byte(wc * 32 + fr, fq * 8);
#define PG8_SA(b, h) (((b) * 2 + (h)) * HTB)
#define PG8_SB(b, h) ((4 + (b) * 2 + (h)) * HTB)
#define PG8_STAGE(bufoff, gbase, voff) do { _Pragma("unroll") for (int _i = 0; _i < 2; ++_i) \
        __builtin_amdgcn_global_load_lds((const unsigned*)((const char*)(gbase) + (voff)[_i]), (PG8_LAS unsigned*)(lds + (bufoff) + ldsw + _i * 8192), 16, 0, 0); } while (0)
#define PG8_LDA(dst, b, h) do { _Pragma("unroll") for (int m = 0; m < 4; ++m) _Pragma("unroll") for (int k = 0; k < 2; ++k) dst[m][k] = *(const PG8_LAS bf16x8*)(lds + PG8_SA(b, h) + aoff + m * 2048 + k * 1024); } while (0)
#define PG8_LDB(dst, b, h) do { _Pragma("unroll") for (int n = 0; n < 2; ++n) _Pragma("unroll") for (int k = 0; k < 2; ++k) dst[n][k] = *(const PG8_LAS bf16x8*)(lds + PG8_SB(b, h) + boff + n * 2048 + k * 1024); } while (0)
#define PG8_MMA(ai, bj, At, Bt) do { __builtin_amdgcn_s_setprio(1); _Pragma("unroll") for (int m = 0; m < 4; ++m) _Pragma("unroll") for (int n = 0; n < 2; ++n) _Pragma("unroll") for (int k = 0; k < 2; ++k) \
        acc[ai][bj][m][n] = __builtin_amdgcn_mfma_f32_16x16x32_bf16(Bt[n][k], At[m][k], acc[ai][bj][m][n], 0, 0, 0); __builtin_amdgcn_s_setprio(0); } while (0)
#define PG8_WAIT_V(n) asm volatile("s_waitcnt vmcnt(" #n ")" ::: "memory")
#define PG8_WAIT_L(n) asm volatile("s_waitcnt lgkmcnt(" #n ")" ::: "memory")
#define PG8_BAR __builtin_amdgcn_s_barrier()
#define PG8_SCHED __builtin_amdgcn_sched_barrier(0)
    Unit cur, nxt; int ui = 0;
    if (!S.next(0, cur)) return;
    f32x4 acc[2][2][4][2];
#pragma unroll
    for (int a = 0; a < 2; ++a)
#pragma unroll
        for (int b = 0; b < 2; ++b)
#pragma unroll
            for (int m = 0; m < 4; ++m)
#pragma unroll
                for (int n = 0; n < 2; ++n) acc[a][b][m][n] = (f32x4){0.f, 0.f, 0.f, 0.f};
    bf16x8 At[4][2], B0[2][2], B1[2][2];
    const char* cA = (const char*)g.A + (size_t)cur.pm * tstep; const char* cB = (const char*)g.Bt + (size_t)cur.pn * tstep;
    S.a_ready(cur);
    if constexpr (SP2) {
        PG8_STAGE(PG8_SB(0, 0), cB, voffB); PG8_STAGE(PG8_SB(0, 1), cB + hstep, voffB); PG8_STAGE(PG8_SA(0, 0), cA, voffA); PG8_STAGE(PG8_SA(0, 1), cA + hstep, voffA);
        if (wr == 1) PG8_BAR;
        PG8_WAIT_V(2); PG8_BAR;
        PG8_STAGE(PG8_SB(1, 0), cB + kstep, voffB); PG8_STAGE(PG8_SA(1, 0), cA + kstep, voffA); PG8_STAGE(PG8_SB(1, 1), cB + hstep + kstep, voffB);
        PG8_WAIT_V(6); PG8_BAR;
    } else {
        PG8_STAGE(PG8_SB(0, 0), cB, voffB); PG8_STAGE(PG8_SA(0, 0), cA, voffA); PG8_STAGE(PG8_SB(0, 1), cB + hstep, voffB); PG8_STAGE(PG8_SA(0, 1), cA + hstep, voffA);
        if (wr == 1) PG8_BAR;
        PG8_WAIT_V(4); PG8_BAR;
        PG8_STAGE(PG8_SB(1, 0), cB + kstep, voffB); PG8_STAGE(PG8_SA(1, 0), cA + kstep, voffA); PG8_STAGE(PG8_SB(1, 1), cB + hstep + kstep, voffB);
        PG8_WAIT_V(6); PG8_BAR;
    }
    for (;;) {
        const bool has_next = S.next(ui + 1, nxt);
        const char* nA = has_next ? (const char*)g.A + (size_t)nxt.pm * tstep : cA; const char* nB = has_next ? (const char*)g.Bt + (size_t)nxt.pn * tstep : cB;
        for (int t = 0; t < nt; t += 2) {
            if constexpr (Epi::HAS_MID) { if (t == (nt >> 1)) E.mid(acc, cur, wr, wc, fr, fq); }
            const bool last = (t == nt - 2);
            const char* a1 = cA + (size_t)(t + 1) * kstep;
            const char* a2 = last ? nA : cA + (size_t)(t + 2) * kstep; const char* b2 = last ? nB : cB + (size_t)(t + 2) * kstep;
            const char* a3 = a2 + kstep; const char* b3 = b2 + kstep;
            if (last && has_next) S.a_ready(nxt);
            if constexpr (SP2) {
            PG8_LDB(B0, 0, 0); PG8_LDB(B1, 0, 1); PG8_SCHED; PG8_LDA(At, 0, 0); PG8_STAGE(PG8_SA(1, 1), a1 + hstep, voffA);
            PG8_WAIT_V(8); PG8_WAIT_L(0); PG8_BAR; PG8_MMA(0, 0, At, B0); PG8_MMA(0, 1, At, B1); PG8_BAR; PG8_SCHED;
            PG8_LDA(At, 0, 1); PG8_STAGE(PG8_SB(0, 0), b2, voffB); PG8_STAGE(PG8_SB(0, 1), b2 + hstep, voffB); PG8_STAGE(PG8_SA(0, 0), a2, voffA);
            PG8_WAIT_V(8); PG8_WAIT_L(0); PG8_BAR; PG8_MMA(1, 0, At, B0); PG8_MMA(1, 1, At, B1); PG8_BAR; PG8_SCHED;
            PG8_LDB(B0, 1, 0); PG8_LDB(B1, 1, 1); PG8_SCHED; PG8_LDA(At, 1, 0); PG8_STAGE(PG8_SA(0, 1), a2 + hstep, voffA);
            PG8_WAIT_V(8); PG8_WAIT_L(0); PG8_BAR; PG8_MMA(0, 0, At, B0); PG8_MMA(0, 1, At, B1); PG8_BAR; PG8_SCHED;
            PG8_LDA(At, 1, 1); PG8_STAGE(PG8_SB(1, 0), b3, voffB); PG8_STAGE(PG8_SB(1, 1), b3 + hstep, voffB); PG8_STAGE(PG8_SA(1, 0), a3, voffA);
            PG8_WAIT_V(8); PG8_WAIT_L(0); PG8_BAR; PG8_MMA(1, 0, At, B0); PG8_MMA(1, 1, At, B1); PG8_BAR; PG8_SCHED;
            } else {
            PG8_LDB(B0, 0, 0); PG8_SCHED; PG8_LDA(At, 0, 0); PG8_STAGE(PG8_SA(1, 1), a1 + hstep, voffA);
            PG8_WAIT_L(8); PG8_BAR; PG8_WAIT_L(0); PG8_MMA(0, 0, At, B0); PG8_BAR; PG8_SCHED;
            PG8_LDB(B1, 0, 1); PG8_STAGE(PG8_SB(0, 0), b2, voffB);
            PG8_BAR; PG8_WAIT_L(0); PG8_MMA(0, 1, At, B1); PG8_BAR;
            PG8_LDA(At, 0, 1); PG8_STAGE(PG8_SA(0, 0), a2, voffA);
            PG8_BAR; PG8_WAIT_L(0); PG8_MMA(1, 0, At, B0); PG8_BAR; PG8_SCHED;
            PG8_STAGE(PG8_SB(0, 1), b2 + hstep, voffB);
            PG8_WAIT_V(6); PG8_BAR; PG8_MMA(1, 1, At, B1); PG8_BAR;
            PG8_LDB(B0, 1, 0); PG8_SCHED; PG8_LDA(At, 1, 0); PG8_STAGE(PG8_SA(0, 1), a2 + hstep, voffA);
            PG8_WAIT_L(8); PG8_BAR; PG8_WAIT_L(0); PG8_MMA(0, 0, At, B0); PG8_BAR; PG8_SCHED;
            PG8_LDB(B1, 1, 1); PG8_STAGE(PG8_SB(1, 0), b3, voffB);
            PG8_BAR; PG8_WAIT_L(0); PG8_MMA(0, 1, At, B1); PG8_BAR;
            PG8_LDA(At, 1, 1); PG8_STAGE(PG8_SA(1, 0), a3, voffA);
            PG8_BAR; PG8_WAIT_L(0); PG8_MMA(1, 0, At, B0); PG8_BAR; PG8_SCHED;
            PG8_STAGE(PG8_SB(1, 1), b3 + hstep, voffB);
            PG8_WAIT_V(6); PG8_BAR; PG8_MMA(1, 1, At, B1); PG8_BAR;
            }
        }
        if constexpr (ALIGN_EPI) { if (wr == 0) PG8_BAR; }
        if constexpr (!Epi::AFTER_DRAIN) { E(acc, cur, wr, wc, fr, fq); S.done(cur); }
        if (!has_next) break;
#pragma unroll
        for (int a = 0; a < 2; ++a)
#pragma unroll
            for (int b = 0; b < 2; ++b)
#pragma unroll
                for (int m = 0; m < 4; ++m)
#pragma unroll
                    for (int n = 0; n < 2; ++n) acc[a][b][m][n] = (f32x4){0.f, 0.f, 0.f, 0.f};
        cur = nxt; cA = nA; cB = nB; ++ui;
        if constexpr (ALIGN_EPI) { if (wr == 1) PG8_BAR; }
    }
    PG8_WAIT_V(0);
    if constexpr (!ALIGN_EPI) { if (wr == 0) PG8_BAR; }
    PG8_BAR;
    if constexpr (Epi::AFTER_DRAIN) { E.fused(acc, cur, wr, wc, fr, fq, lds, wid, lane); S.done(cur); }
#undef PG8_SA
#undef PG8_SB
#undef PG8_STAGE
#undef PG8_LDA
#undef PG8_LDB
#undef PG8_MMA
#undef PG8_WAIT_V
#undef PG8_WAIT_L
#undef PG8_BAR
#undef PG8_SCHED
}
}

#define LAS __attribute__((address_space(3)))
typedef unsigned short bf16;
typedef pg8::f32x4 f32x4;
typedef pg8::u32x4 u32x4;
typedef unsigned u32x2 __attribute__((ext_vector_type(2)));
typedef float f32x2 __attribute__((ext_vector_type(2)));
typedef short s16x8 __attribute__((ext_vector_type(8)));
typedef float f32x16 __attribute__((ext_vector_type(16)));
typedef short s16x4 __attribute__((ext_vector_type(4)));
typedef short v4i16_t __attribute__((ext_vector_type(4)));
using pg8::Unit;
using pg8::cvt_pk_bf16;

constexpr int NB = 4, S = 8192, T = NB * S, DM = 1024, NH = 8, FFN = 2816;
constexpr int IN_W = 4008, IN_WP = 4096;
constexpr float EPS = 1e-6f;
constexpr float LOG2E = 1.4426950408889634f;
constexpr float QSC_A = 0.125f * LOG2E;
constexpr float QSC_B = 0.10206207261596577f * LOG2E;
constexpr int NWAVES = 8, NTHREADS = 512;
constexpr int LDS_BYTES = 147456;

constexpr size_t MiB = 1u << 20;
constexpr size_t WS_WIN = 1 * MiB, WS_WQ = 9 * MiB, WS_WKV = 9 * MiB + 512 * 1024, WS_WA = 10 * MiB, WS_WB = 11 * MiB, WS_WOUT = 12 * MiB,
                 WS_WGU = 14 * MiB, WS_WDN = 25 * MiB;
constexpr size_t WS_KR = 31 * MiB, WS_LOGF = 35 * MiB, WS_C = 36 * MiB, WS_PSQ = 37 * MiB, WS_PSKV = 37 * MiB + 512 * 1024, WS_CS = 38 * MiB,
                 WS_PSH = 42 * MiB, WS_KMAX = 44 * MiB;
constexpr size_t WS_XN = 48 * MiB;
constexpr size_t WS_YA = 48 * MiB, WS_YB = 80 * MiB;
constexpr size_t WS_QA = 112 * MiB, WS_KA = 144 * MiB, WS_VTA = 176 * MiB;
constexpr size_t WS_MERGED = 112 * MiB;
constexpr size_t WS_CQ = 208 * MiB, WS_CKV = 224 * MiB;
constexpr size_t WS_GA = 232 * MiB, WS_GB = 296 * MiB;
constexpr size_t WS_QB = 360 * MiB, WS_KB = 408 * MiB, WS_VTB = 456 * MiB;
constexpr size_t WS_HB = 360 * MiB, WS_H2B = 424 * MiB;
constexpr size_t WS_ACT = 48 * MiB;
constexpr size_t WS_END = 488 * MiB;

__device__ __forceinline__ int pos16(int k) { return (k & 3) | ((k & 4) << 1) | ((k & 8) >> 1); }
__device__ __forceinline__ unsigned bf1(float v) { return cvt_pk_bf16(v, 0.f) & 0xffffu; }
__device__ __forceinline__ u32x4 pack8(f32x4 a, f32x4 b) { u32x4 w; w.x = cvt_pk_bf16(a[0], a[1]); w.y = cvt_pk_bf16(a[2], a[3]); w.z = cvt_pk_bf16(b[0], b[1]); w.w = cvt_pk_bf16(b[2], b[3]); return w; }
__device__ __forceinline__ u32x2 pack4(f32x4 a) { u32x2 w; w.x = cvt_pk_bf16(a[0], a[1]); w.y = cvt_pk_bf16(a[2], a[3]); return w; }
__device__ __forceinline__ float bflo(unsigned w) { return __uint_as_float(w << 16); }
__device__ __forceinline__ float bfhi(unsigned w) { return __uint_as_float(w & 0xffff0000u); }
__device__ __forceinline__ float sigmoidf_(float z) { return __builtin_amdgcn_rcpf(1.f + __expf(-z)); }
__device__ __forceinline__ float sumsq4(f32x4 v) { return (v[0] * v[0] + v[1] * v[1]) + (v[2] * v[2] + v[3] * v[3]); }
__device__ __forceinline__ float red_fq(float s) { s += __shfl_xor(s, 16); s += __shfl_xor(s, 32); return s; }

#define ACC_T const f32x4 (&acc)[2][2][4][2]
#define FOR_AI_M _Pragma("unroll") for (int ai = 0; ai < 2; ++ai) _Pragma("unroll") for (int m = 0; m < 4; ++m)

__device__ __forceinline__ unsigned vt_lane_off(int fr, int fq) { return (unsigned)((8 * fq * S + pos16(fr & ~1)) * 2 + (fr & 1) * S * 2); }
__device__ __forceinline__ void store_vt(bf16* VT, int urow, int col, unsigned loff, f32x4 v, int fr) {
    const int b = urow >> 13, s = urow & (S - 1);
    unsigned char* ub = (unsigned char*)VT + ((size_t)(b * 512 + col) * S + s) * 2;
    const bool odd = (fr & 1) != 0;
    const float mine0 = odd ? v[1] : v[0], mine1 = odd ? v[3] : v[2];
    const float give0 = odd ? v[0] : v[1], give1 = odd ? v[2] : v[3];
    const float got0 = __shfl_xor(give0, 1), got1 = __shfl_xor(give1, 1);
    const unsigned w0 = odd ? cvt_pk_bf16(got0, mine0) : cvt_pk_bf16(mine0, got0);
    const unsigned w1 = odd ? cvt_pk_bf16(got1, mine1) : cvt_pk_bf16(mine1, got1);
    *(unsigned*)(ub + loff) = w0;
    *(unsigned*)(ub + (size_t)2 * S * 2 + loff) = w1;
}

struct EpiIn {
    static constexpr bool PERM = true, AFTER_DRAIN = false, HAS_MID = false;
    unsigned char* ws; const float *b_forget, *b_gate;
    __device__ __forceinline__ void operator()(ACC_T, const Unit& u, int wr, int wc, int fr, int fq) const {
        asm volatile("" : "+v"(fr), "+v"(fq));
        bf16 *QA = (bf16*)(ws + WS_QA), *KA = (bf16*)(ws + WS_KA), *VTA = (bf16*)(ws + WS_VTA), *CQ = (bf16*)(ws + WS_CQ), *CKV = (bf16*)(ws + WS_CKV), *GA = (bf16*)(ws + WS_GA), *GB = (bf16*)(ws + WS_GB);
        float *KR = (float*)(ws + WS_KR), *LOGF = (float*)(ws + WS_LOGF), *PSQ = (float*)(ws + WS_PSQ), *PSKV = (float*)(ws + WS_PSKV);
        const int pn = u.pn, rbase = u.pm * 256 + wr * 64 + fr, cl = wc * 32 + 8 * fq;
        if (pn < 4) {
            bf16* dst = pn < 2 ? QA : KA; const float sc = pn < 2 ? QSC_A : 1.f; const int c0 = (pn & 1) * 256 + cl;
            FOR_AI_M { int row = rbase + ai * 128 + m * 16; asm volatile("" : "+v"(row) :: "memory");
#pragma unroll
                for (int bj = 0; bj < 2; ++bj) *(u32x4*)(dst + (size_t)row * 512 + c0 + bj * 128) = pack8(acc[ai][bj][m][0] * sc, acc[ai][bj][m][1] * sc); }
        } else if (pn < 6) {
            const int c0 = (pn & 1) * 256 + cl;
            FOR_AI_M { int row = rbase + ai * 128 + m * 16; asm volatile("" : "+v"(row) :: "memory");
#pragma unroll
                for (int bj = 0; bj < 2; ++bj) *(u32x4*)(VTA + (size_t)row * 512 + c0 + bj * 128) = pack8(acc[ai][bj][m][0], acc[ai][bj][m][1]); }
        } else if (pn == 6) {
            FOR_AI_M { int row = rbase + ai * 128 + m * 16; asm volatile("" : "+v"(row) :: "memory"); float s = 0.f;
#pragma unroll
                for (int bj = 0; bj < 2; ++bj) { *(u32x4*)(CQ + (size_t)row * 256 + cl + bj * 128) = pack8(acc[ai][bj][m][0], acc[ai][bj][m][1]); s += sumsq4(acc[ai][bj][m][0]) + sumsq4(acc[ai][bj][m][1]); }
                s = red_fq(s); if (fq == 0) PSQ[(size_t)row * 4 + wc] = s; }
        } else if (pn == 7) {
            FOR_AI_M { int row = rbase + ai * 128 + m * 16; asm volatile("" : "+v"(row) :: "memory");
                *(u32x4*)(CKV + (size_t)row * 128 + cl) = pack8(acc[ai][0][m][0], acc[ai][0][m][1]);
                float s = sumsq4(acc[ai][0][m][0]) + sumsq4(acc[ai][0][m][1]); s = red_fq(s); if (fq == 0) PSKV[(size_t)row * 4 + wc] = s;
                if (wc == 0) { *(f32x4*)(KR + (size_t)row * 32 + 8 * fq) = acc[ai][1][m][0]; *(f32x4*)(KR + (size_t)row * 32 + 8 * fq + 4) = acc[ai][1][m][1]; }
                else if (wc == 1 && fq == 0) {
#pragma unroll
                    for (int n = 0; n < 2; ++n) { f32x4 o;
#pragma unroll
                        for (int e = 0; e < 4; ++e) { const float z = acc[ai][1][m][n][e] + b_forget[4 * n + e]; o[e] = fminf(z, 0.f) - __logf(1.f + __expf(-fabsf(z))); }
                        *(f32x4*)(LOGF + (size_t)row * 8 + 4 * n) = o; } } }
        } else {
            bf16* dst = pn < 12 ? GA : GB; const int c0 = ((pn - 8) & 3) * 256 + cl; const float* bg = b_gate + (pn < 12 ? 0 : DM) + c0;
            f32x4 bv[2][2];
#pragma unroll
            for (int bj = 0; bj < 2; ++bj)
#pragma unroll
                for (int n = 0; n < 2; ++n) bv[bj][n] = *(const f32x4*)(bg + bj * 128 + 4 * n);
            FOR_AI_M { int row = rbase + ai * 128 + m * 16; asm volatile("" : "+v"(row) :: "memory");
#pragma unroll
                for (int bj = 0; bj < 2; ++bj) { f32x4 a = acc[ai][bj][m][0] + bv[bj][0], b = acc[ai][bj][m][1] + bv[bj][1];
#pragma unroll
                    for (int e = 0; e < 4; ++e) { a[e] = fmaxf(sigmoidf_(a[e]), 1e-30f); b[e] = fmaxf(sigmoidf_(b[e]), 1e-30f); }
                    *(u32x4*)(dst + (size_t)row * DM + c0 + bj * 128) = pack8(a, b); } }
        }
    }
};

struct EpiQup {
    static constexpr bool PERM = false, AFTER_DRAIN = false, HAS_MID = false;
    bf16 *QN, *QR; const float* PSQ; const float* CS;
    __device__ __forceinline__ void operator()(ACC_T, const Unit& u, int wr, int wc, int fr, int fq) const {
        asm volatile("" : "+v"(fr), "+v"(fq));
        const int pn = u.pn, rbase = u.pm * 256 + wr * 64 + fr;
        FOR_AI_M { int row = rbase + ai * 128 + m * 16; asm volatile("" : "+v"(row) :: "memory");
            const f32x4 ps = *(const f32x4*)(PSQ + (size_t)row * 4);
            const float r = rsqrtf(((ps[0] + ps[1]) + (ps[2] + ps[3])) * (1.f / 256.f) + EPS) * QSC_B;
            if (pn < 2) {
#pragma unroll
                for (int bj = 0; bj < 2; ++bj)
#pragma unroll
                    for (int n = 0; n < 2; ++n) { const int c = pn * 256 + bj * 128 + wc * 32 + 16 * n + 4 * fq; *(u32x2*)(QN + (size_t)row * 512 + c) = pack4(acc[ai][bj][m][n] * r); }
            } else {
                const f32x4 cs0 = *(const f32x4*)(CS + (size_t)row * 32 + 8 * fq), cs1 = *(const f32x4*)(CS + (size_t)row * 32 + 8 * fq + 4);
                const f32x4 c = {cs0[0], cs0[2], cs1[0], cs1[2]}, sn = {cs0[1], cs0[3], cs1[1], cs1[3]};
#pragma unroll
                for (int bj = 0; bj < 2; ++bj) { const int hh = 4 * bj + wc; const f32x4 x1 = acc[ai][bj][m][0], x2 = acc[ai][bj][m][1];
                    *(u32x2*)(QR + (size_t)row * 256 + hh * 32 + 4 * fq) = pack4((x1 * c - x2 * sn) * r);
                    *(u32x2*)(QR + (size_t)row * 256 + hh * 32 + 16 + 4 * fq) = pack4((x2 * c + x1 * sn) * r); }
            } }
    }
};
struct EpiKVup {
    static constexpr bool PERM = true, AFTER_DRAIN = false, HAS_MID = false;
    bf16 *KN, *VTB; const float* PSKV;
    __device__ __forceinline__ void operator()(ACC_T, const Unit& u, int wr, int wc, int fr, int fq) const {
        asm volatile("" : "+v"(fr), "+v"(fq));
        const int pn = u.pn, rbase = u.pm * 256 + wr * 64 + fr, cl = wc * 32 + 8 * fq;
        FOR_AI_M { int row = rbase + ai * 128 + m * 16; asm volatile("" : "+v"(row) :: "memory");
            const f32x4 ps = *(const f32x4*)(PSKV + (size_t)row * 4);
            const float r = rsqrtf(((ps[0] + ps[1]) + (ps[2] + ps[3])) * (1.f / 128.f) + EPS);
            if (pn < 2) {
#pragma unroll
                for (int bj = 0; bj < 2; ++bj) *(u32x4*)(KN + (size_t)row * 512 + pn * 256 + bj * 128 + cl) = pack8(acc[ai][bj][m][0] * r, acc[ai][bj][m][1] * r);
            } else {
#pragma unroll
                for (int bj = 0; bj < 2; ++bj)
#pragma unroll
                    for (int n = 0; n < 2; ++n) store_vt(VTB, u.pm * 256 + wr * 64 + ai * 128 + m * 16, (pn - 2) * 256 + wc * 32 + bj * 128 + 4 * n, vt_lane_off(fr, fq), acc[ai][bj][m][n] * r, fr);
            } }
    }
};
struct EpiMerge {
    static constexpr bool PERM = true, AFTER_DRAIN = false, HAS_MID = true;
    const bf16 *GA_, *GB_; bf16* MG;
    __device__ __forceinline__ void mid(f32x4 (&acc)[2][2][4][2], const Unit& u, int wr, int wc, int fr, int fq) const {
        asm volatile("" : "+v"(fr), "+v"(fq));
        const int rbase = u.pm * 256 + wr * 64 + fr, c0 = u.pn * 256 + wc * 32 + 8 * fq;
        FOR_AI_M { int row = rbase + ai * 128 + m * 16; asm volatile("" : "+v"(row) :: "memory");
#pragma unroll
            for (int bj = 0; bj < 2; ++bj) { const size_t off = (size_t)row * DM + c0 + bj * 128; const u32x4 a = *(const u32x4*)(GA_ + off), b = *(const u32x4*)(GB_ + off);
                const f32x4 a0 = {bflo(a.x), bfhi(a.x), bflo(a.y), bfhi(a.y)}, a1 = {bflo(a.z), bfhi(a.z), bflo(a.w), bfhi(a.w)};
                const f32x4 b0 = {bflo(b.x), bfhi(b.x), bflo(b.y), bfhi(b.y)}, b1 = {bflo(b.z), bfhi(b.z), bflo(b.w), bfhi(b.w)};
                f32x4 r0, r1;
#pragma unroll
                for (int e = 0; e < 4; ++e) { r0[e] = a0[e] * __builtin_amdgcn_rcpf(b0[e]); r1[e] = a1[e] * __builtin_amdgcn_rcpf(b1[e]); }
                acc[ai][bj][m][0] *= r0; acc[ai][bj][m][1] *= r1; } }
    }
    __device__ __forceinline__ void operator()(ACC_T, const Unit& u, int wr, int wc, int fr, int fq) const {
        asm volatile("" : "+v"(fr), "+v"(fq));
        const int rbase = u.pm * 256 + wr * 64 + fr, c0 = u.pn * 256 + wc * 32 + 8 * fq;
        FOR_AI_M { int row = rbase + ai * 128 + m * 16; asm volatile("" : "+v"(row) :: "memory");
#pragma unroll
            for (int bj = 0; bj < 2; ++bj) { const size_t off = (size_t)row * DM + c0 + bj * 128; const u32x4 g = *(const u32x4*)(GB_ + off);
                const f32x4 g0 = {bflo(g.x), bfhi(g.x), bflo(g.y), bfhi(g.y)}, g1 = {bflo(g.z), bfhi(g.z), bflo(g.w), bfhi(g.w)};
                *(u32x4*)(MG + off) = pack8(acc[ai][bj][m][0] * g0, acc[ai][bj][m][1] * g1); } }
    }
};
struct EpiOut {
    static constexpr bool PERM = true, AFTER_DRAIN = false, HAS_MID = false;
    const float* X; bf16* HB; float* PS;
    __device__ __forceinline__ void operator()(ACC_T, const Unit& u, int wr, int wc, int fr, int fq) const {
        asm volatile("" : "+v"(fr), "+v"(fq));
        const int rbase = u.pm * 256 + wr * 64 + fr, c0 = u.pn * 256 + wc * 32 + 8 * fq;
        FOR_AI_M { int row = rbase + ai * 128 + m * 16; asm volatile("" : "+v"(row) :: "memory"); float s = 0.f;
#pragma unroll
            for (int bj = 0; bj < 2; ++bj) { const size_t off = (size_t)row * DM + c0 + bj * 128;
                const f32x4 h0 = *(const f32x4*)(X + off) + acc[ai][bj][m][0], h1 = *(const f32x4*)(X + off + 4) + acc[ai][bj][m][1];
                *(u32x4*)(HB + off) = pack8(h0, h1); s += sumsq4(h0) + sumsq4(h1); }
            s = red_fq(s); if (fq == 0) PS[((size_t)u.pn * T + row) * 4 + wc] = s; }
    }
};
struct EpiDown {
    static constexpr bool PERM = true, AFTER_DRAIN = false, HAS_MID = false;
    const bf16* HB; bf16* H2; float* PS;
    __device__ __forceinline__ void operator()(ACC_T, const Unit& u, int wr, int wc, int fr, int fq) const {
        asm volatile("" : "+v"(fr), "+v"(fq));
        const int rbase = u.pm * 256 + wr * 64 + fr, c0 = u.pn * 256 + wc * 32 + 8 * fq;
        FOR_AI_M { int row = rbase + ai * 128 + m * 16; asm volatile("" : "+v"(row) :: "memory"); float s = 0.f;
#pragma unroll
            for (int bj = 0; bj < 2; ++bj) { const size_t off = (size_t)row * DM + c0 + bj * 128; const u32x4 hq = *(const u32x4*)(HB + off);
                const f32x4 b0 = {bflo(hq.x), bfhi(hq.x), bflo(hq.y), bfhi(hq.y)}, b1 = {bflo(hq.z), bfhi(hq.z), bflo(hq.w), bfhi(hq.w)};
                const f32x4 h0 = b0 + acc[ai][bj][m][0], h1 = b1 + acc[ai][bj][m][1];
                *(u32x4*)(H2 + off) = pack8(h0, h1); s += sumsq4(h0) + sumsq4(h1); }
            s = red_fq(s); if (fq == 0) PS[((size_t)u.pn * T + row) * 4 + wc] = s; }
    }
};
struct EpiGU {
    static constexpr bool PERM = true, AFTER_DRAIN = false, HAS_MID = false;
    const float* PS; bf16* ACT;
    __device__ __forceinline__ void operator()(ACC_T, const Unit& u, int wr, int wc, int fr, int fq) const {
        asm volatile("" : "+v"(fr), "+v"(fq));
        const int rbase = u.pm * 256 + wr * 64 + fr, c0 = u.pn * 128 + wc * 32 + 8 * fq;
        FOR_AI_M { int row = rbase + ai * 128 + m * 16; asm volatile("" : "+v"(row) :: "memory");
            const f32x4* pp = (const f32x4*)(PS + (size_t)row * 4); const f32x4 p0 = pp[0], p1 = pp[T], p2 = pp[2 * T], p3 = pp[3 * T];
            const f32x4 pt = (p0 + p1) + (p2 + p3);
            const float r = rsqrtf(((pt[0] + pt[1]) + (pt[2] + pt[3])) * (1.f / 1024.f) + EPS);
            f32x4 o[2];
#pragma unroll
            for (int n = 0; n < 2; ++n)
#pragma unroll
                for (int e = 0; e < 4; ++e) { const float g = acc[ai][0][m][n][e] * r, up = acc[ai][1][m][n][e] * r; o[n][e] = g * sigmoidf_(g) * up; }
            *(u32x4*)(ACT + (size_t)row * FFN + c0) = pack8(o[0], o[1]); }
    }
};

namespace att {
__device__ __forceinline__ int crow(int r, int hi) { return (r & 3) + 8 * (r >> 2) + 4 * hi; }
__device__ __forceinline__ float max3f(float a, float b, float c) { return fmaxf(fmaxf(a, b), c); }

template <int NDC, bool FOX>
__device__ __forceinline__ void attn_unit(LAS unsigned char* lds, unsigned char* ws, int bh, int qb) {
    asm volatile("" : "+s"(ws));
    const bf16* Q = (const bf16*)(ws + (FOX ? WS_QA : WS_QB)); const bf16* Q2 = (const bf16*)(ws + WS_QB) + (size_t)T * 512;
    const bf16* K = (const bf16*)(ws + (FOX ? WS_KA : WS_KB)); const bf16* VT = (const bf16*)(ws + (FOX ? WS_VTA : WS_VTB));
    const float* Cc = (const float*)(ws + WS_C); bf16* O = (bf16*)(ws + WS_YA) + (FOX ? 0 : 512);
    constexpr int DQK = NDC * 16, PITCH = 8 * DQK, KS = FOX ? 176 : DQK * 2 + 16, VS = 144, KBYTES = 64 * KS, VBYTES = FOX ? 8192 : 64 * VS, VBASE = 2 * KBYTES, KCH = NDC * 2, NKC = 64 * KCH;
    constexpr float THR = 8.f, CUT = 40.f;
    int tid_ = threadIdx.x; asm volatile("" : "+v"(tid_));
    const int tid = tid_, lane = tid & 63, r32 = lane & 31, hi = lane >> 5, wid = __builtin_amdgcn_readfirstlane(tid >> 6);
    const int b = bh >> 3, h = bh & 7, q0 = qb * 256;
    const size_t rowbase = (size_t)b * S;
    const int NT = q0 / 64 + 4, ntw = (q0 + 32 * wid) / 64 + 1;
    const int kr0 = tid / KCH, kc0 = tid % KCH, kr1 = (tid + 512) / KCH, kc1 = (tid + 512) % KCH;
    const bool has2 = (NKC > 512) && (tid + 512 < NKC);
    const int kr1s = has2 ? kr1 : 0, kc1s = has2 ? kc1 : 0;
    const unsigned ko0 = (FOX || kc0 < 8) ? (unsigned)(((int)rowbase + kr0) * 512 + h * 64 + kc0 * 8) * 2u : (unsigned)(T * 512 + ((int)rowbase + kr0) * 32 + (kc0 - 8) * 8) * 2u;
    const unsigned ko1 = (kc1s < 8) ? (unsigned)(((int)rowbase + kr1s) * 512 + h * 64 + kc1s * 8) * 2u : (unsigned)(T * 512 + ((int)rowbase + kr1s) * 32 + (kc1s - 8) * 8) * 2u;
    const unsigned kst0 = (FOX || kc0 < 8) ? 64u * 512u * 2u : 64u * 32u * 2u, kst1 = (kc1s < 8) ? 64u * 512u * 2u : 64u * 32u * 2u;
    const int vr = tid >> 3, vc = tid & 7;
    const unsigned vo = FOX ? (unsigned)(((int)rowbase + vr) * 512 + h * 64 + vc * 8) * 2u : (unsigned)((bh * 64 + vr) * S + vc * 8) * 2u;
    const unsigned vst = FOX ? 64u * 512u * 2u : 128u;
    const float* cg_ = Cc + (size_t)bh * S;
    float cref = 0.f; if (FOX) cref = cg_[q0];
    const unsigned kl0 = kr0 * KS + kc0 * 16, kl1 = kr1 * KS + kc1 * 16, vl = FOX ? VBASE + (vc >> 2) * 4096 + (vr >> 4) * 1024 + (vr & 15) * 64 + (vc & 3) * 16 : VBASE + vr * VS + vc * 16, bl = tid * KS + 128;
#define ATT_GP(base, off) ((const __attribute__((address_space(1))) u32x4*)((const __attribute__((address_space(1))) unsigned char*)(base) + (off)))
    u32x4 kA0, kA1 = {0, 0, 0, 0}, vA, kB0, kB1 = {0, 0, 0, 0}, vB; float bA = 0.f, bB = 0.f;
#define ATT_LOAD(t, K0, K1, V, B) do { K0 = *ATT_GP(K, ko0 + (unsigned)(t) * kst0); if (has2) K1 = *ATT_GP(K, ko1 + (unsigned)(t) * kst1); V = *ATT_GP(VT, vo + (unsigned)(t) * vst); \
        if (FOX && tid < 64) B = (cref - ((const __attribute__((address_space(1))) float*)cg_)[(t) * 64 + tid]) * LOG2E; } while (0)
#define ATT_STORE(t, K0, K1, V, B) do { const unsigned bufo_ = ((t) & 1) * KBYTES; *(LAS u32x4*)(lds + bufo_ + kl0) = K0; if (has2) *(LAS u32x4*)(lds + bufo_ + kl1) = K1; \
        *(LAS u32x4*)(lds + ((t) & 1) * VBYTES + vl) = V; \
        if (FOX && tid < 64) { const unsigned h0 = bf1(B); const float r1 = B - bflo(h0); const unsigned h1 = bf1(r1); const float r2 = r1 - bflo(h1); const unsigned h2 = bf1(r2); \
            *(LAS u32x4*)(lds + bufo_ + bl) = (u32x4){h0 | (h1 << 16), h2 | 0x3F800000u, 0x3F803F80u, 0u}; } } while (0)
    const unsigned koff = r32 * KS + hi * 16, kaoff = r32 * KS + 128, voff = FOX ? VBASE + ((lane >> 4) & 1) * 32 + (lane & 3) * 8 + (4 * hi + ((lane & 15) >> 2)) * 64 : VBASE + r32 * VS + hi * 16;
    const unsigned one2_ = hi == 0 ? 0x3F803F80u : 0u;
    u32x4 qaug_w = {one2_, one2_ & 0xffffu, 0u, 0u};
    const s16x8 kaug_c = {0, 0, 0, (short)0x3F80, (short)0x3F80, (short)0x3F80, 0, 0};
#define ATT_SETM(mref) do { const float nm_ = -(mref); const unsigned h0 = bf1(nm_); const float r1 = nm_ - bflo(h0); const unsigned h1 = bf1(r1); const float r2 = r1 - bflo(h1); const unsigned h2 = bf1(r2); \
        qaug_w.y = hi == 0 ? ((one2_ & 0xffffu) | (h0 << 16)) : 0u; qaug_w.z = hi == 0 ? (h1 | (h2 << 16)) : 0u; } while (0)
    s16x8 qr[NDC];
    constexpr int NOPS = 2 * (NDC + 1);
#define ATT_KF(i, kb_) ((((i) >> 1) < NDC) ? *(const LAS s16x8*)(lds + (kb_) + koff + ((((i) >> 1) < NDC) ? ((i) >> 1) : 0) * 32 + ((i) & 1) * 32 * KS) \
                                            : (FOX ? *(const LAS s16x8*)(lds + (kb_) + kaoff + ((i) & 1) * 32 * KS) : kaug_c))
#define ATT_QKOP(i, N0, N1) do { constexpr int i_ = (i), d_ = i_ >> 1, blk_ = i_ & 1; if (i_ < NOPS) { \
        const s16x8 qf_ = d_ < NDC ? qr[d_ < NDC ? d_ : 0] : __builtin_bit_cast(s16x8, qaug_w); \
        if (blk_ == 0) N0 = __builtin_amdgcn_mfma_f32_32x32x16_bf16(ATT_KF(i_ < NOPS ? i_ : 0, kq_), qf_, d_ == 0 ? (f32x16){} : N0, 0, 0, 0); \
        else N1 = __builtin_amdgcn_mfma_f32_32x32x16_bf16(ATT_KF(i_ < NOPS ? i_ : 0, kq_), qf_, d_ == 0 ? (f32x16){} : N1, 0, 0, 0); } } while (0)
#define ATT_QK(N0, N1, t) do { const unsigned kq_ = ((t) & 1) * KBYTES; \
        ATT_QKOP(0, N0, N1); ATT_QKOP(1, N0, N1); ATT_QKOP(2, N0, N1); ATT_QKOP(3, N0, N1); ATT_QKOP(4, N0, N1); ATT_QKOP(5, N0, N1); ATT_QKOP(6, N0, N1); ATT_QKOP(7, N0, N1); \
        if (FOX) { ATT_QKOP(8, N0, N1); ATT_QKOP(9, N0, N1); } \
        else { ATT_QKOP(8, N0, N1); ATT_QKOP(9, N0, N1); ATT_QKOP(10, N0, N1); ATT_QKOP(11, N0, N1); \
               if (aug_on) { ATT_QKOP(12, N0, N1); ATT_QKOP(13, N0, N1); } } } while (0)
    ATT_LOAD(NT - 1, kA0, kA1, vA, bA);
    { const size_t qrow = rowbase + q0 + wid * 32 + r32;
      const bf16* qp = Q + qrow * 512 + h * 64 + hi * 8;
#pragma unroll
      for (int d0 = 0; d0 < 4; ++d0) qr[d0] = *(const s16x8*)(qp + d0 * 16);
      if (NDC > 4) { const bf16* qp2 = Q2 + qrow * 256 + h * 32 + hi * 8;
#pragma unroll
        for (int d0 = 4; d0 < NDC; ++d0) qr[d0] = *(const s16x8*)(qp2 + (d0 - 4) * 16); } }
    ATT_STORE(NT - 1, kA0, kA1, vA, bA);
    volatile LAS unsigned* vote = (volatile LAS unsigned*)(lds + 131072 + 128);
    if (FOX && lane < 2) vote[lane * 8 + wid] = 0u;
    ATT_LOAD(NT - 2, kB0, kB1, vB, bB);
    float m_ref = 0.f; f32x16 o0 = {}, o1 = {}; f32x2 lacc = {0.f, 0.f};
    bool aug_on = FOX;
    const int qabs = q0 + wid * 32 + r32;
    float qkb = 0.f;
    if (FOX) { float ssq = 0.f;
#pragma unroll
        for (int d0 = 0; d0 < 4; ++d0) { const u32x4 w = __builtin_bit_cast(u32x4, qr[d0]);
#pragma unroll
            for (int e = 0; e < 4; ++e) { const float a = bflo(w[e]), b = bfhi(w[e]); ssq += a * a + b * b; } }
        { auto rr = __builtin_amdgcn_permlane32_swap(__float_as_uint(ssq), __float_as_uint(ssq), false, false); ssq = __uint_as_float(rr[0]) + __uint_as_float(rr[1]); }
        const float kmax2 = __uint_as_float(((const unsigned*)(ws + WS_KMAX))[bh]);
        qkb = sqrtf(ssq * kmax2) * 1.001f + 0.01f; }
#define ATT_ROWMAX(rm, P0, P1) do { rm = max3f(P0[0], P0[1], P1[0]); \
        _Pragma("unroll") for (int r = 1; r < 16; ++r) rm = max3f(rm, P0[r], P1[r]); \
        rm = fmaxf(rm, P1[0]); rm = fmaxf(rm, P1[1]); \
        { auto rr = __builtin_amdgcn_permlane32_swap(__float_as_uint(rm), __float_as_uint(rm), false, false); rm = fmaxf(__uint_as_float(rr[0]), __uint_as_float(rr[1])); } } while (0)
#define ATT_EXPC(c, P) do { constexpr int o_ = ((c) & 1) * 8; \
        _Pragma("unroll") for (int r = 0; r < 8; ++r) P[o_ + r] = __builtin_amdgcn_exp2f(P[o_ + r]); \
        lacc += (f32x2){P[o_], P[o_ + 1]} + (f32x2){P[o_ + 2], P[o_ + 3]}; lacc += (f32x2){P[o_ + 4], P[o_ + 5]} + (f32x2){P[o_ + 6], P[o_ + 7]}; \
        u32x4 w; w.x = cvt_pk_bf16(P[o_], P[o_ + 1]); w.y = cvt_pk_bf16(P[o_ + 2], P[o_ + 3]); w.z = cvt_pk_bf16(P[o_ + 4], P[o_ + 5]); w.w = cvt_pk_bf16(P[o_ + 6], P[o_ + 7]); \
        pa[c] = __builtin_bit_cast(s16x8, w); } while (0)
#define ATT_EXPCD(c, P, dl_) do { constexpr int o_ = ((c) & 1) * 8; \
        _Pragma("unroll") for (int r = 0; r < 8; ++r) P[o_ + r] = __builtin_amdgcn_exp2f(P[o_ + r] - (dl_)); \
        lacc += (f32x2){P[o_], P[o_ + 1]} + (f32x2){P[o_ + 2], P[o_ + 3]}; lacc += (f32x2){P[o_ + 4], P[o_ + 5]} + (f32x2){P[o_ + 6], P[o_ + 7]}; \
        u32x4 w; w.x = cvt_pk_bf16(P[o_], P[o_ + 1]); w.y = cvt_pk_bf16(P[o_ + 2], P[o_ + 3]); w.z = cvt_pk_bf16(P[o_ + 4], P[o_ + 5]); w.w = cvt_pk_bf16(P[o_ + 6], P[o_ + 7]); \
        pa[c] = __builtin_bit_cast(s16x8, w); __builtin_amdgcn_sched_barrier(0); } while (0)
#define ATT_SOFTD(P0, P1, dl_) do { ATT_EXPCD(0, P0, dl_); ATT_EXPCD(1, P0, dl_); ATT_EXPCD(2, P1, dl_); ATT_EXPCD(3, P1, dl_); } while (0)
#define ATT_SOFT(P0, P1) do { ATT_EXPC(0, P0); ATT_EXPC(1, P0); ATT_EXPC(2, P1); ATT_EXPC(3, P1); } while (0)
#define ATT_VTR(p_) __builtin_bit_cast(s16x4, __builtin_amdgcn_ds_read_tr16_b64_v4i16((LAS v4i16_t*)(p_)))
#define ATT_VLOAD(t) do { const unsigned vb_ = ((t) & 1) * VBYTES; \
        if (FOX) { _Pragma("unroll") for (int g = 0; g < 4; ++g) _Pragma("unroll") for (int dh = 0; dh < 2; ++dh) { \
            const s16x4 lo_ = ATT_VTR(lds + vb_ + voff + dh * 4096 + g * 1024), hi_ = ATT_VTR(lds + vb_ + voff + dh * 4096 + g * 1024 + 512); \
            vf[2 * g + dh] = (s16x8){lo_[0], lo_[1], lo_[2], lo_[3], hi_[0], hi_[1], hi_[2], hi_[3]}; } } \
        else { _Pragma("unroll") for (int g = 0; g < 4; ++g) { vf[2 * g] = *(const LAS s16x8*)(lds + vb_ + voff + g * 32); vf[2 * g + 1] = *(const LAS s16x8*)(lds + vb_ + voff + 32 * VS + g * 32); } } } while (0)
#define ATT_PV() do { __builtin_amdgcn_sched_barrier(0); \
        _Pragma("unroll") for (int g = 0; g < 4; ++g) { \
            o0 = __builtin_amdgcn_mfma_f32_32x32x16_bf16(vf[2 * g], pa[g], o0, 0, 0, 0); \
            o1 = __builtin_amdgcn_mfma_f32_32x32x16_bf16(vf[2 * g + 1], pa[g], o1, 0, 0, 0); } } while (0)
#define ATT_STEP(t, LK0, LK1, LV, LB, SK0, SK1, SV, SB_) do { \
        asm volatile("s_waitcnt lgkmcnt(0)\n\ts_barrier" ::: "memory");     \
        if (FOX) { const u32x4 va_ = *(const volatile LAS u32x4*)(vote + (((t) + 1) & 1) * 8), vb_ = *(const volatile LAS u32x4*)(vote + (((t) + 1) & 1) * 8 + 4); \
            if ((va_.x & va_.y & va_.z & va_.w & vb_.x & vb_.y & vb_.z & vb_.w) != 0u) goto att_done; }     \
        if ((t) >= 2) ATT_LOAD((t) - 2, LK0, LK1, LV, LB); \
        if ((t) < ntw) { \
            s16x8 pa[4], vf[8]; float rm; f32x16 p0, p1; \
            if (FOX && (t) < ntw - 1 && __all(qkb + (cref - cg_[(t) * 64 + 63]) * LOG2E - m_ref < -CUT)) {     \
                if (lane == 0) vote[((t) & 1) * 8 + wid] = 1u; \
            } else { \
            ATT_QK(p0, p1, t); \
            if ((t) == ntw - 1) {                             \
                if (FOX) { int qa_ = qabs; asm volatile("" : "+v"(qa_)); const int kb = (t) * 64 + 4 * hi; \
                    _Pragma("unroll") for (int r = 0; r < 16; ++r) { const int kv = kb + (r & 3) + 8 * (r >> 2); if (kv > qa_) p0[r] = -1e30f; if (kv + 32 > qa_) p1[r] = -1e30f; } } \
                ATT_ROWMAX(rm, p0, p1); \
                if (FOX || __any(fabsf(rm) > THR)) { m_ref = rm; ATT_SETM(m_ref); aug_on = true; \
                    _Pragma("unroll") for (int r = 0; r < 16; ++r) { p0[r] -= rm; p1[r] -= rm; } \
                    ATT_SOFT(p0, p1); ATT_VLOAD(t); ATT_PV(); \
                } else { ATT_SOFT(p0, p1); ATT_VLOAD(t); ATT_PV(); }     \
            } else { \
                ATT_ROWMAX(rm, p0, p1); \
                if (FOX && __all(rm < -CUT)) {               \
                } else if (__builtin_expect(__any(rm > THR), 0)) { const float dl = fmaxf(rm, 0.f); m_ref += dl; ATT_SETM(m_ref); aug_on = true; \
                    const float al = __builtin_amdgcn_exp2f(-dl); o0 *= al; o1 *= al; lacc *= al; \
                    __builtin_amdgcn_sched_barrier(0); \
                    ATT_SOFTD(p0, p1, dl); ATT_VLOAD(t); ATT_PV(); \
                } else { ATT_SOFT(p0, p1); ATT_VLOAD(t); ATT_PV(); } \
            } \
            } \
        } \
        if ((t) >= 1) ATT_STORE((t) - 1, SK0, SK1, SV, SB_); } while (0)
    for (int t = NT - 1; t >= 1; t -= 2) {
        ATT_STEP(t, kA0, kA1, vA, bA, kB0, kB1, vB, bB);
        ATT_STEP(t - 1, kB0, kB1, vB, bB, kA0, kA1, vA, bA);
    }
att_done:
    asm volatile("s_waitcnt lgkmcnt(0)\n\ts_barrier" ::: "memory");
#undef ATT_ROWMAX
#undef ATT_QKOP
#undef ATT_EXPC
#undef ATT_SOFT
#undef ATT_SOFTD
#undef ATT_EXPCD
#undef ATT_VLOAD
#undef ATT_VTR
#undef ATT_PV
#undef ATT_KF
#undef ATT_STEP
#undef ATT_LOAD
#undef ATT_GP
#undef ATT_STORE
#undef ATT_QK
#undef ATT_SETM
    float l_ = lacc[0] + lacc[1];
    { auto rr = __builtin_amdgcn_permlane32_swap(__float_as_uint(l_), __float_as_uint(l_), false, false); l_ = __uint_as_float(rr[0]) + __uint_as_float(rr[1]); }
    const float inv = 1.f / l_;
    int lane_o = lane; asm volatile("" : "+v"(lane_o));
    LAS unsigned char* ost = lds + 65536 + wid * 4608;
    { const int q_ = lane_o & 31, hi_ = lane_o >> 5;
#pragma unroll
      for (int i = 0; i < 4; ++i) {
        const f32x4 a = {o0[4 * i] * inv, o0[4 * i + 1] * inv, o0[4 * i + 2] * inv, o0[4 * i + 3] * inv};
        const f32x4 c = {o1[4 * i] * inv, o1[4 * i + 1] * inv, o1[4 * i + 2] * inv, o1[4 * i + 3] * inv};
        *(LAS u32x2*)(ost + q_ * 144 + (8 * i + 4 * hi_) * 2) = pack4(a); *(LAS u32x2*)(ost + q_ * 144 + 64 + (8 * i + 4 * hi_) * 2) = pack4(c);
      } }
    asm volatile("s_waitcnt lgkmcnt(0)" ::: "memory");
#pragma unroll
    for (int it = 0; it < 4; ++it) { const int row = it * 8 + (lane_o >> 3), ch = lane_o & 7;
        const u32x4 v = *(const LAS u32x4*)(ost + row * 144 + ch * 16);
        *(u32x4*)(O + (rowbase + q0 + wid * 32 + row) * 1024 + h * 64 + ch * 8) = v; }
    asm volatile("s_waitcnt lgkmcnt(0)" ::: "memory");
}
}

__device__ __forceinline__ float wave_sum(float v) {
#pragma unroll
    for (int o = 1; o < 64; o <<= 1) v += __shfl_xor(v, o);
    return v;
}
enum { MAP_ID = 0, MAP_IN, MAP_QUP, MAP_KVUP, MAP_GATE, MAP_UP };
__device__ __forceinline__ int map_row(int kind, int n) {
    switch (kind) {
        case MAP_IN:
            if (n < 1536) return n;
            if (n < 1544) return 1952 + (n - 1536);
            if (n < 1800) return 1536 + (n - 1544);
            if (n < 1928) return 1792 + (n - 1800);
            if (n < 1960) return 1920 + (n - 1928);
            return 2048 + (n - 1960);
        case MAP_QUP: { const int hh = n / 96, j = n % 96; return j < 64 ? hh * 64 + j : 512 + hh * 32 + (j - 64); }
        case MAP_KVUP: { const int hh = n >> 7, j = n & 127; return j < 64 ? hh * 64 + j : 512 + hh * 64 + (j - 64); }
        case MAP_GATE: return 256 * (n >> 7) + (n & 127);
        case MAP_UP: return 256 * (n >> 7) + 128 + (n & 127);
        default: return n;
    }
}
__device__ __forceinline__ void transpose_item(const float* W, int K, int N, bf16* WT, int kind, const float* gain, LAS float* scr, int item, int lane, int ldk = 0, int koff = 0) {
    if (ldk == 0) ldk = K;
    const int nblk = (N + 31) / 32, kb = item / nblk, nb = item % nblk, k0 = 64 * kb, n0 = 32 * nb;
    const int nl = n0 + (lane & 31);
#pragma unroll
    for (int i = 0; i < 32; ++i) { const int kk = 2 * i + (lane >> 5); float v = nl < N ? W[(size_t)(k0 + kk) * N + nl] : 0.f; if (gain) v *= gain[k0 + kk]; scr[kk * 33 + (lane & 31)] = v; }
    asm volatile("s_waitcnt lgkmcnt(0)" ::: "memory");
    const int c = lane & 7;
#pragma unroll
    for (int j = 0; j < 4; ++j) { const int n = (lane >> 3) + 8 * j; const LAS float* s = scr + (8 * c) * 33 + n;
        if (n0 + n < N) { u32x4 o; o.x = cvt_pk_bf16(s[0 * 33], s[1 * 33]); o.y = cvt_pk_bf16(s[2 * 33], s[3 * 33]); o.z = cvt_pk_bf16(s[4 * 33], s[5 * 33]); o.w = cvt_pk_bf16(s[6 * 33], s[7 * 33]);
            *(u32x4*)(WT + (size_t)map_row(kind, n0 + n) * ldk + koff + k0 + 8 * c) = o; } }
    asm volatile("s_waitcnt lgkmcnt(0)" ::: "memory");
}
__device__ __forceinline__ void cossin(double ang, float& c, float& s) {
    const double kd = __builtin_rint(ang * 0.6366197723675814);
    double r = __builtin_fma(-kd, 1.5707963267948966, ang); r = __builtin_fma(-kd, 6.123233995736766e-17, r);
    const int q = (int)kd & 3; const float x = (float)r, x2 = x * x;
    const float sn = x * (1.f + x2 * (-1.f / 6.f + x2 * (1.f / 120.f + x2 * (-1.f / 5040.f + x2 * (1.f / 362880.f)))));
    const float cs = 1.f + x2 * (-0.5f + x2 * (1.f / 24.f + x2 * (-1.f / 720.f + x2 * (1.f / 40320.f + x2 * (-1.f / 3628800.f)))));
    c = (q == 0) ? cs : (q == 1) ? -sn : (q == 2) ? -cs : sn;
    s = (q == 0) ? sn : (q == 1) ? cs : (q == 2) ? -sn : -cs;
}

#define XB_TMO      128
#define XB_XCNT(j)  (256  + 64 * (j))
#define XB_XSUB(j)  (1280 + 64 * (j))
#define XB_XGEN(j)  (2304 + 64 * (j))
#define XB_TOP      3328
#define XB_TOPGEN   3392
#define XCD_BAR_WORDS 3456
#define XB_SPIN_CAP (1u << 18)

__device__ __forceinline__ unsigned xb_ld(unsigned* p)              { return __hip_atomic_load(p, __ATOMIC_RELAXED, __HIP_MEMORY_SCOPE_AGENT); }
__device__ __forceinline__ unsigned xb_add(unsigned* p, unsigned v) { return __hip_atomic_fetch_add(p, v, __ATOMIC_RELAXED, __HIP_MEMORY_SCOPE_AGENT); }
__device__ __forceinline__ unsigned xb_xcc_id() { return (unsigned)__builtin_amdgcn_s_getreg((3 << 11) | 20) & 0xFu; }
#define XB_SPIN(cond, bar) do { unsigned _sp = 0; while (cond) { __builtin_amdgcn_s_sleep(1); \
    if ((++_sp & 255u) == 0u) { if (xb_ld(&(bar)[XB_TMO])) break; if (_sp > XB_SPIN_CAP) { atomicAdd(&(bar)[XB_TMO], 1u); break; } } } } while (0)

struct XcdBarrier {
    unsigned* bar; unsigned x;
    volatile LAS unsigned* st;
};

__device__ __forceinline__ XcdBarrier xcd_barrier_post(unsigned* bar, volatile LAS unsigned* st) {
    XcdBarrier b; b.bar = bar; b.x = xb_xcc_id(); b.st = st;
    if (threadIdx.x == 0) (void)xb_add(&bar[XB_XCNT(b.x)], 1u);
    return b;
}
__device__ __forceinline__ void xcd_barrier_complete(unsigned* bar, unsigned x, unsigned& nloc, unsigned& nx) {
    const unsigned G = gridDim.x * gridDim.y * gridDim.z;
    unsigned sum, cnt, mine, sp = 0u;
    for (;;) {
        sum = 0u; cnt = 0u; mine = 0u;
#pragma unroll
        for (unsigned j = 0; j < 16; ++j) { const unsigned c = xb_ld(&bar[XB_XCNT(j)]); sum += c; cnt += (c > 0u) ? 1u : 0u; mine = (j == x) ? c : mine; }
        if (sum == G) break;
        __builtin_amdgcn_s_sleep(1);
        if ((++sp & 255u) == 0u) { if (xb_ld(&bar[XB_TMO])) break; if (sp > XB_SPIN_CAP) { atomicAdd(&bar[XB_TMO], 1u); break; } }
    }
    nloc = mine > 0u ? mine : 1u; nx = cnt > 0u ? cnt : 1u;
}

__device__ __forceinline__ void xcd_barrier(const XcdBarrier& b) {
    asm volatile("s_waitcnt vmcnt(0)" ::: "memory");
    __syncthreads();
    if (threadIdx.x == 0) {
        unsigned* bar = b.bar;
        __builtin_amdgcn_s_waitcnt(0);
        unsigned nloc = b.st[0], nx = b.st[1];
        if (nloc == 0u) { xcd_barrier_complete(bar, b.x, nloc, nx); b.st[0] = nloc; b.st[1] = nx; }
        const unsigned old = xb_add(&bar[XB_XSUB(b.x)], 1u);
        const unsigned gen = old / nloc;
        if (old + 1u == (gen + 1u) * nloc) {
            __builtin_amdgcn_fence(__ATOMIC_RELEASE, "agent");
            asm volatile("s_waitcnt vmcnt(0)" ::: "memory");
            const unsigned og = xb_add(&bar[XB_TOP], 1u);
            const unsigned tg = og / nx;
            if (og + 1u == (tg + 1u) * nx) xb_add(&bar[XB_TOPGEN], 1u);
            else XB_SPIN(xb_ld(&bar[XB_TOPGEN]) == tg, bar);
            __builtin_amdgcn_fence(__ATOMIC_ACQUIRE, "agent");
            xb_add(&bar[XB_XGEN(b.x)], 1u);
            asm volatile("s_waitcnt vmcnt(0)" ::: "memory");
        } else {
            XB_SPIN(xb_ld(&bar[XB_XGEN(b.x)]) == gen, bar);
            __builtin_amdgcn_fence(__ATOMIC_ACQUIRE, "agent");
            asm volatile("s_waitcnt vmcnt(0)" ::: "memory");
        }
    }
    __syncthreads();
}

struct Args { const float* in[18]; float* out; unsigned char* ws; int ph_lo, ph_hi; };
enum { I_X = 0, I_POS, I_GMIX, I_WIN, I_BF, I_GQ, I_WQUP, I_GKV, I_WKVUP, I_WA, I_WB, I_BG, I_WOUT, I_GFFN, I_WG, I_WU, I_WD, I_GFIN };
constexpr int N_PHASES = 9;

template <class Epi> __device__ __forceinline__ void run_gemm(LAS unsigned char* lds, const bf16* A, const bf16* Bt, int M, int N, int K, int G, const Epi& E) {
    pg8::Gemm g{A, Bt, M, N, K}; pg8::StaticOrder So; So.init(M, N, G, (int)blockIdx.x);
    pg8::gemm_phase<Epi, pg8::StaticOrder, true, true>(lds, g, So, E);
}


#define P_(T_, off) ((T_*)(args.ws + (off)))
#define Win_t P_(bf16, WS_WIN)
#define Wq_t P_(bf16, WS_WQ)
#define Wkv_t P_(bf16, WS_WKV)
#define Wa_t P_(bf16, WS_WA)
#define Wb_t P_(bf16, WS_WB)
#define Wout_t P_(bf16, WS_WOUT)
#define Wgu_t P_(bf16, WS_WGU)
#define Wdn_t P_(bf16, WS_WDN)
#define KR P_(float, WS_KR)
#define LOGF P_(float, WS_LOGF)
#define CC P_(float, WS_C)
#define PSQ P_(float, WS_PSQ)
#define PSKV P_(float, WS_PSKV)
#define CS P_(float, WS_CS)
#define PSH P_(float, WS_PSH)
#define XN P_(bf16, WS_XN)
#define YA P_(bf16, WS_YA)
#define YB P_(bf16, WS_YB)
#define QA P_(bf16, WS_QA)
#define KA P_(bf16, WS_KA)
#define VTA P_(bf16, WS_VTA)
#define MG P_(bf16, WS_MERGED)
#define CQ P_(bf16, WS_CQ)
#define CKV P_(bf16, WS_CKV)
#define GA P_(bf16, WS_GA)
#define GB P_(bf16, WS_GB)
#define QB P_(bf16, WS_QB)
#define KB P_(bf16, WS_KB)
#define VTB P_(bf16, WS_VTB)
#define HB P_(bf16, WS_HB)
#define H2B P_(bf16, WS_H2B)
#define ACT P_(bf16, WS_ACT)
__global__ void __launch_bounds__(NTHREADS, 2) mega_fwd(Args args) {
    __builtin_assume(__builtin_amdgcn_workitem_id_y() == 0); __builtin_assume(__builtin_amdgcn_workitem_id_z() == 0);
    extern __shared__ __attribute__((aligned(16))) unsigned char lds_raw[];
    LAS unsigned char* lds = (LAS unsigned char*)lds_raw;
    cg::grid_group grid = cg::this_grid();
    const int wave = __builtin_amdgcn_readfirstlane((int)threadIdx.x >> 6);
    const int G = gridDim.x, bx = blockIdx.x, vcu = (G % 8 == 0) ? (bx % 8) * (G / 8) + bx / 8 : bx;
#define TID_INIT int tid = threadIdx.x; asm volatile("" : "+v"(tid)); const int lane = tid & 63, gt = bx * NTHREADS + tid; (void)lane; (void)gt
    const int lo = args.ph_lo, hi_ = args.ph_hi;
    volatile LAS unsigned* bar_st = (volatile LAS unsigned*)(lds + 131072 + 64);
    if (threadIdx.x < 2) bar_st[threadIdx.x] = 0u;
    __syncthreads();
    XcdBarrier xbar = xcd_barrier_post((unsigned*)args.ws, bar_st);
#ifdef ONLY_PHASE
#define IN(k) ((k) == ONLY_PHASE)
#else
#define IN(k) (lo <= (k) && (k) < hi_)
#endif
    if (lo < 0) grid.sync();
#define SEAM(k) do { if (IN(k) && IN((k) + 1)) xcd_barrier(xbar); } while (0)
    const int gw = vcu * NWAVES + wave, NGW = G * NWAVES;
    const int NGT = G * NTHREADS;

    if (IN(0)) { TID_INIT;
        LAS float* scr = (LAS float*)(lds + wave * 16384);
        constexpr int I_IN = 16 * 126, I_Q = 4 * 24, I_KV = 2 * 32, I_AB = 8 * 32, I_O = 16 * 32, I_GU = 16 * 88, I_D = 44 * 32;
        constexpr int NIT = I_IN + I_Q + I_KV + 2 * I_AB + I_O + 2 * I_GU + I_D;
        for (int it = gw; it < NIT; it += NGW) {
            int r = it;
            if (r < I_IN) { transpose_item(args.in[I_WIN], DM, IN_W, Win_t, MAP_IN, nullptr, scr, r, lane); continue; } r -= I_IN;
            if (r < I_Q) { transpose_item(args.in[I_WQUP], 256, 768, Wq_t, MAP_QUP, args.in[I_GQ], scr, r, lane); continue; } r -= I_Q;
            if (r < I_KV) { transpose_item(args.in[I_WKVUP], 128, 1024, Wkv_t, MAP_KVUP, args.in[I_GKV], scr, r, lane); continue; } r -= I_KV;
            if (r < I_AB) { transpose_item(args.in[I_WA], 512, DM, Wa_t, MAP_ID, nullptr, scr, r, lane, 1024, 0); continue; } r -= I_AB;
            if (r < I_AB) { transpose_item(args.in[I_WB], 512, DM, Wa_t, MAP_ID, nullptr, scr, r, lane, 1024, 512); continue; } r -= I_AB;
            if (r < I_O) { transpose_item(args.in[I_WOUT], DM, DM, Wout_t, MAP_ID, nullptr, scr, r, lane); continue; } r -= I_O;
            if (r < I_GU) { transpose_item(args.in[I_WG], DM, FFN, Wgu_t, MAP_GATE, args.in[I_GFFN], scr, r, lane); continue; } r -= I_GU;
            if (r < I_GU) { transpose_item(args.in[I_WU], DM, FFN, Wgu_t, MAP_UP, args.in[I_GFFN], scr, r, lane); continue; } r -= I_GU;
            transpose_item(args.in[I_WD], FFN, DM, Wdn_t, MAP_ID, nullptr, scr, r, lane);
        }
        if (gt < 32) ((unsigned*)(args.ws + WS_KMAX))[gt] = 0u;
        for (int i = gt; i < 88 * DM / 8; i += NGT) *(u32x4*)(Win_t + (size_t)1960 * DM + (size_t)i * 8) = (u32x4){0u, 0u, 0u, 0u};
        { const float* gm = args.in[I_GMIX]; f32x4 gv[4];
#pragma unroll
          for (int j = 0; j < 4; ++j) gv[j] = *(const f32x4*)(gm + 4 * lane + 256 * j);
          for (int mrow = gw; mrow < T; mrow += 4 * NGW) {
            f32x4 v[4][4]; float ss[4];
#pragma unroll
            for (int q = 0; q < 4; ++q) { const f32x4* xr = (const f32x4*)(args.in[I_X] + (size_t)(mrow + q * NGW) * DM) + lane;
#pragma unroll
              for (int j = 0; j < 4; ++j) v[q][j] = xr[64 * j]; }
#pragma unroll
            for (int q = 0; q < 4; ++q) { float s = 0.f;
#pragma unroll
              for (int j = 0; j < 4; ++j) s += sumsq4(v[q][j]);
              ss[q] = s; }
#pragma unroll
            for (int o = 1; o < 64; o <<= 1) {
#pragma unroll
              for (int q = 0; q < 4; ++q) ss[q] += __shfl_xor(ss[q], o); }
#pragma unroll
            for (int q = 0; q < 4; ++q) { const float rstd = rsqrtf(ss[q] * (1.f / DM) + EPS);
#pragma unroll
              for (int j = 0; j < 4; ++j) *(u32x2*)(XN + (size_t)(mrow + q * NGW) * DM + 4 * lane + 256 * j) = pack4(v[q][j] * rstd * gv[j]); }
          } }
        { const int* pos = (const int*)args.in[I_POS];
          constexpr double IF[16] = {1.0, 0.5623413251903491, 0.31622776601683794, 0.1778279410038923, 0.1, 0.05623413251903491, 0.03162277660168379, 0.01778279410038923,
                                     0.01, 0.005623413251903491, 0.0031622776601683794, 0.0017782794100389228, 0.001, 0.0005623413251903491, 0.00031622776601683794, 0.00017782794100389227};
          for (int t = gt; t < T; t += NGT) { const double p = (double)pos[t];
#pragma unroll
            for (int j = 0; j < 16; j += 2) { float c0, s0, c1, s1; cossin(p * IF[j], c0, s0); cossin(p * IF[j + 1], c1, s1); *(f32x4*)(CS + (size_t)t * 32 + 2 * j) = (f32x4){c0, s0, c1, s1}; } } }
    }
    SEAM(0);
    if (IN(1)) {
        EpiIn E{args.ws, args.in[I_BF], args.in[I_BG]};
#if defined(DUP_PHASE) && DUP_PHASE == 1
        run_gemm(lds, XN, Win_t, T, IN_WP, DM, G, E);
#endif
        run_gemm(lds, XN, Win_t, T, IN_WP, DM, G, E);
    }
    SEAM(1);
    if (IN(2)) { TID_INIT;
        LAS double* sw = (LAS double*)lds;
        for (int j = vcu; j < NB * NH; j += G) {
            const int b = j >> 3, h = j & 7; const float* src = LOGF + ((size_t)b * S + tid * 16) * 8 + h;
            double v[16]; double run = 0.0;
#pragma unroll
            for (int i = 0; i < 16; ++i) { run += (double)src[i * 8]; v[i] = run; }
            double xs = run;
#pragma unroll
            for (int o = 1; o < 64; o <<= 1) { const double y = __shfl_up(xs, o); if (lane >= o) xs += y; }
            if (lane == 63) sw[wave] = xs;
            __syncthreads();
            double base = 0.0;
            for (int w = 0; w < wave; ++w) base += sw[w];
            const double excl = base + xs - run;
            float* dst = CC + (size_t)j * S + tid * 16;
#pragma unroll
            for (int i = 0; i < 16; i += 4) *(f32x4*)(dst + i) = (f32x4){(float)(excl + v[i]), (float)(excl + v[i + 1]), (float)(excl + v[i + 2]), (float)(excl + v[i + 3])};
            __syncthreads();
        }
        for (int idx = gt; idx < T * 8; idx += NGT) {
            const int hh = idx >> 15, t = idx & (T - 1); const u32x4* kp = (const u32x4*)(KA + (size_t)t * 512 + hh * 64); float ssq = 0.f;
#pragma unroll
            for (int c8 = 0; c8 < 8; ++c8) { const u32x4 w = kp[c8];
#pragma unroll
                for (int e = 0; e < 4; ++e) { const float a = bflo(w[e]), b = bfhi(w[e]); ssq += a * a + b * b; } }
#pragma unroll
            for (int o = 1; o < 64; o <<= 1) ssq = fmaxf(ssq, __shfl_xor(ssq, o));
            if (lane == 0) atomicMax((unsigned*)(args.ws + WS_KMAX) + ((t >> 13) * 8 + hh), __float_as_uint(ssq));
        }
        { bf16* KR2 = KB + (size_t)T * 512;
          for (int idx = gt; idx < T * 4; idx += NGT) {
            const int t = idx >> 2, g4 = idx & 3; const f32x4* kr = (const f32x4*)(KR + (size_t)t * 32); const f32x4* cs = (const f32x4*)(CS + (size_t)t * 32);
            const f32x4 x1 = kr[g4], x2 = kr[4 + g4], ca = cs[2 * g4], cb = cs[2 * g4 + 1];
            const f32x4 c = {ca[0], ca[2], cb[0], cb[2]}, sn = {ca[1], ca[3], cb[1], cb[3]};
            *(u32x2*)(KR2 + (size_t)t * 32 + 4 * g4) = pack4(x1 * c - x2 * sn); *(u32x2*)(KR2 + (size_t)t * 32 + 16 + 4 * g4) = pack4(x2 * c + x1 * sn);
          } }
        __syncthreads();
#if !defined(P2_PART) || P2_PART == 1
        { EpiQup E{QB, QB + (size_t)T * 512, PSQ, CS}; run_gemm(lds, CQ, Wq_t, T, 768, 256, G, E); }
#endif
#if !defined(P2_PART) || P2_PART == 2
        { EpiKVup E{KB, VTB, PSKV}; run_gemm(lds, CKV, Wkv_t, T, 1024, 128, G, E); }
#endif
    }
    SEAM(2);
    if (IN(3)) {
#ifdef DUP_P3
      for (int rep_ = 0; rep_ < 2; ++rep_) {
#endif
#define ATT_UNITS(CALL) do { \
        if (G == 256) { const int xcd_ = vcu >> 5, c_ = vcu & 31; \
            for (int r_ = 0; r_ < 4; ++r_) { const int bh = xcd_ * 4 + r_, c2_ = (c_ + 16) & 31; const int qb = r_ == 0 ? c_ : r_ == 1 ? 31 - c_ : r_ == 2 ? c2_ : 31 - c2_; CALL; } } \
        else { for (int i = vcu; i < 1024; i += G) { const int bh = (i & 255) >> 3, s_ = i & 7, rd = i >> 8; const int qb = rd == 0 ? s_ : rd == 1 ? 15 - s_ : rd == 2 ? 16 + s_ : 31 - s_; CALL; } } } while (0)
        ATT_UNITS((att::attn_unit<4, true>(lds, args.ws, bh, qb)));
        __syncthreads();
        ATT_UNITS((att::attn_unit<6, false>(lds, args.ws, bh, qb)));
#undef ATT_UNITS
        __syncthreads();
#ifdef DUP_P3
      }
#endif
    }
    SEAM(3);
    if (IN(4)) {
        { EpiMerge E{GA, GB, MG}; run_gemm(lds, YA, Wa_t, T, DM, 1024, G, E); }
    }
    SEAM(4);
    if (IN(5)) { EpiOut E{args.in[I_X], HB, PSH}; run_gemm(lds, MG, Wout_t, T, DM, DM, G, E); }
    SEAM(5);
    if (IN(6)) { EpiGU E{PSH, ACT};
#if defined(DUP_PHASE) && DUP_PHASE == 6
        run_gemm(lds, HB, Wgu_t, T, 2 * FFN, DM, G, E);
#endif
        run_gemm(lds, HB, Wgu_t, T, 2 * FFN, DM, G, E); }
    SEAM(6);
    if (IN(7)) { EpiDown E{HB, H2B, PSH}; run_gemm(lds, ACT, Wdn_t, T, DM, FFN, G, E); }
    SEAM(7);
    if (IN(8)) { TID_INIT;
        const float* gm = args.in[I_GFIN]; f32x4 gv[4];
#pragma unroll
        for (int j = 0; j < 4; ++j) gv[j] = *(const f32x4*)(gm + 4 * lane + 256 * j);
        for (int mrow = gw; mrow < T; mrow += 4 * NGW) {
            u32x2 v[4][4]; float ss[4];
#pragma unroll
            for (int q = 0; q < 4; ++q) { const int row = mrow + q * NGW; const u32x2* hr = (const u32x2*)(H2B + (size_t)row * DM) + lane;
#pragma unroll
              for (int j = 0; j < 4; ++j) v[q][j] = hr[64 * j];
              const f32x4* pp = (const f32x4*)(PSH + (size_t)row * 4); const f32x4 pt = (pp[0] + pp[T]) + (pp[2 * T] + pp[3 * T]);
              ss[q] = (pt[0] + pt[1]) + (pt[2] + pt[3]); }
#pragma unroll
            for (int q = 0; q < 4; ++q) { const float rstd = rsqrtf(ss[q] * (1.f / DM) + EPS); f32x4* xw = (f32x4*)(args.out + (size_t)(mrow + q * NGW) * DM) + lane;
#pragma unroll
              for (int j = 0; j < 4; ++j) { const f32x4 hv = {bflo(v[q][j].x), bfhi(v[q][j].x), bflo(v[q][j].y), bfhi(v[q][j].y)}; xw[64 * j] = hv * rstd * gv[j]; } }
        }
    }
#undef IN
#undef SEAM
}

#ifdef DBG_STOP
#ifndef DBG_N
#define DBG_N (T * DM)
#endif
__global__ void dbg_dump(const unsigned short* src, float* dst, int n) {
    for (int i = blockIdx.x * blockDim.x + threadIdx.x; i < n; i += gridDim.x * blockDim.x) dst[i] = i < DBG_N ? __uint_as_float((unsigned)src[i] << 16) : 0.f;
}
#endif
#ifndef MK_COOP
#define MK_COOP 1
#endif
extern "C" void kernel_launch(void* const* d_in, const int* in_sizes, int n_in, void* d_out, int out_size, void* d_ws, size_t ws_size, hipStream_t stream) {
    static int grid = 0;
    if (grid == 0) {
        if (n_in != 18 || in_sizes[0] != T * DM || out_size != T * DM || ws_size < WS_END) { fprintf(stderr, "kernel_launch: unexpected shapes (n_in %d, in0 %d, out %d, ws %zu)\n", n_in, n_in > 0 ? in_sizes[0] : -1, out_size, ws_size); grid = -1; return; }
        int dev = 0, cus = 0, per_cu = 0;
        if (hipGetDevice(&dev) != hipSuccess || hipDeviceGetAttribute(&cus, hipDeviceAttributeMultiprocessorCount, dev) != hipSuccess) { grid = -1; return; }
        if (hipFuncSetAttribute((const void*)mega_fwd, hipFuncAttributeMaxDynamicSharedMemorySize, LDS_BYTES) != hipSuccess) { fprintf(stderr, "kernel_launch: hipFuncSetAttribute failed\n"); grid = -1; return; }
        if (hipOccupancyMaxActiveBlocksPerMultiprocessor(&per_cu, (const void*)mega_fwd, NTHREADS, LDS_BYTES) != hipSuccess || per_cu < 1) { fprintf(stderr, "kernel_launch: occupancy query says %d\n", per_cu); per_cu = 1; }
        (void)hipGetLastError();
        grid = cus * 1;
    }
    if (grid < 0) return;
    Args a{};
    for (int i = 0; i < 18; ++i) a.in[i] = (const float*)d_in[i];
    a.out = (float*)d_out; a.ws = (unsigned char*)d_ws;
#if MK_COOP
    a.ph_lo = 0; a.ph_hi = N_PHASES;
    if (hipMemsetAsync(d_ws, 0, 16384, stream) != hipSuccess) { fprintf(stderr, "kernel_launch: memset of the barrier words failed\n"); return; }
    void* kargs[] = {&a};
    hipError_t e = hipLaunchCooperativeKernel((const void*)mega_fwd, dim3(grid), dim3(NTHREADS), kargs, LDS_BYTES, stream);
    if (e != hipSuccess) fprintf(stderr, "cooperative launch failed: %s (grid %d)\n", hipGetErrorString(e), grid);
#else
#ifdef DBG_STOP
    for (int p = 0; p <= DBG_STOP; ++p) { a.ph_lo = p; a.ph_hi = p + 1; hipLaunchKernelGGL(mega_fwd, dim3(grid), dim3(NTHREADS), LDS_BYTES, stream, a); }
#ifndef DBG_NO_DUMP
    hipLaunchKernelGGL(dbg_dump, dim3(2048), dim3(256), 0, stream, (const unsigned short*)((unsigned char*)d_ws + (size_t)DBG_OFF * MiB), (float*)d_out, T * DM);
#endif
#else
    for (int p = 0; p < N_PHASES; ++p) { a.ph_lo = p; a.ph_hi = p + 1; hipLaunchKernelGGL(mega_fwd, dim3(grid), dim3(NTHREADS), LDS_BYTES, stream, a); }
#endif
#endif
}
```
